# Optimizing an MI355X kernel written in HIP

```python
import math
import jax, jax.numpy as jnp
from jax import lax
import numpy as np

D_MODEL = 1024
BATCH = 32
SEQ = 2048
DEPTH = 2

GRID_W = 64
CTX_LEN = 256
N_EVEN = (DEPTH + 1) // 2
N_ODD = DEPTH // 2

MLA_HEADS = 8
MLA_NOPE = 64
MLA_ROPE = 32
MLA_V = 64
MLA_Q_RANK = 384
MLA_KV_RANK = 256
DIFF_HEADS = 4
DIFF_HEAD_DIM = 64
DIFF_V_DIM = 2 * DIFF_HEAD_DIM
WIN_Q_HEADS = 8
WIN_KV_HEADS = 2
WIN_GROUP = WIN_Q_HEADS // WIN_KV_HEADS
WIN_HEAD_DIM = 64
WINDOW = 128
BLOCK = 128
HYENA_CH = 512
HYENA_ORDER = 2
HYENA_BANDS = 16
HYENA_EMB = 1 + 2 * HYENA_BANDS
HYENA_HIDDEN = 64
HYENA_DECAY_TARGET = 1e-2
HYENA_FAST_PCT = 0.3
HYENA_SLOW_PCT = 1.5
D_FF = 2816

ROPE_BASE = 10000.0
NORM_EPS = 1e-6
NEG_INF = -1e30
Q_BLOCK = 128

EVEN_SPLIT = (MLA_Q_RANK, MLA_KV_RANK, MLA_ROPE, DIFF_HEADS * 2 * DIFF_HEAD_DIM, DIFF_HEADS * 2 * DIFF_HEAD_DIM, DIFF_HEADS * DIFF_V_DIM)
ODD_SPLIT = (WIN_Q_HEADS * WIN_HEAD_DIM, WIN_KV_HEADS * WIN_HEAD_DIM, WIN_KV_HEADS * WIN_HEAD_DIM, (HYENA_ORDER + 1) * HYENA_CH)
EVEN_IN = sum(EVEN_SPLIT)
ODD_IN = sum(ODD_SPLIT)
MIX_WIDTH = MLA_HEADS * MLA_V + DIFF_HEADS * DIFF_V_DIM

kernel_name = "hybrid_mla_diff_swa_hyena_prefix_block"


def split_cols(t, widths):
    return jnp.split(t, [int(i) for i in np.cumsum(widths)[:-1]], axis=-1)


def rms_norm(x, g):
    x32 = x.astype(jnp.float32)
    y = x32 * lax.rsqrt(jnp.mean(x32 * x32, axis=-1, keepdims=True) + NORM_EPS)
    return (y * g.astype(jnp.float32)).astype(x.dtype)


def modulate(h, shift, scale):
    return h * (1.0 + scale) + shift


def dwconv3(x, w, b):
    xp = jnp.pad(x, ((0, 0), (1, 1), (0, 0)))
    return xp[:, :-2] * w[0] + xp[:, 1:-1] * w[1] + xp[:, 2:] * w[2] + b


def axial_rope(length, rot_dim):
    rows = length // GRID_W
    row = jnp.repeat(jnp.arange(rows), GRID_W).astype(jnp.float32)
    col = jnp.tile(jnp.arange(GRID_W), rows).astype(jnp.float32)
    quarter = rot_dim // 4
    inv = ROPE_BASE ** (-jnp.arange(quarter, dtype=jnp.float32) / quarter)
    ang = jnp.concatenate([row[:, None] * inv, col[:, None] * inv], axis=-1)
    return jnp.cos(ang), jnp.sin(ang)


def apply_rope(x, cos, sin):
    half = x.shape[-1] // 2
    extra = x.ndim - 3
    cos = cos.reshape(cos.shape[0], *([1] * extra), half).astype(x.dtype)
    sin = sin.reshape(sin.shape[0], *([1] * extra), half).astype(x.dtype)
    x1, x2 = x[..., :half], x[..., half:]
    return jnp.concatenate([x1 * cos - x2 * sin, x1 * sin + x2 * cos], axis=-1)


def attend(q, k, v, scale):
    s = jnp.einsum("bqhd,bkhd->bhqk", q, k).astype(jnp.float32) * scale
    p = jax.nn.softmax(s, axis=-1).astype(v.dtype)
    return jnp.einsum("bhqk,bkhd->bqhd", p, v)


def map_query_blocks(fn, *qs):
    b, length = qs[0].shape[:2]
    nb = length // Q_BLOCK
    blocks = tuple(jnp.swapaxes(q.reshape(b, nb, Q_BLOCK, *q.shape[2:]), 0, 1) for q in qs)
    out = lax.map(lambda args: fn(*args), blocks)
    return jnp.swapaxes(out, 0, 1).reshape(b, length, *out.shape[3:])


def gqa_sink_attend(q, k, v, sink, mask):
    s = jnp.einsum("bqhgd,bkhd->bhgqk", q, k).astype(jnp.float32) * (WIN_HEAD_DIM ** -0.5)
    if mask is not None:
        s = jnp.where(mask, s, NEG_INF)
    sink_col = jnp.broadcast_to(sink.astype(jnp.float32)[None, :, :, None, None], s.shape[:-1] + (1,))
    p = jax.nn.softmax(jnp.concatenate([s, sink_col], axis=-1), axis=-1)[..., :-1].astype(v.dtype)
    return jnp.einsum("bhgqk,bkhd->bqhgd", p, v)


def window_attention(q, k, v, k_ctx, v_ctx, sink):
    b, length = q.shape[:2]
    nb = length // BLOCK
    n_ctx = k_ctx.shape[1]

    def to_blocks(t):
        return jnp.swapaxes(t.reshape(b, nb, BLOCK, *t.shape[2:]), 0, 1)

    def windows(t):
        tp = jnp.pad(t, ((0, 0), (BLOCK, BLOCK), (0, 0), (0, 0))).reshape(b, nb + 2, BLOCK, *t.shape[2:])
        w = jnp.concatenate([tp[:, :-2], tp[:, 1:-1], tp[:, 2:]], axis=2)
        return jnp.swapaxes(w, 0, 1)

    q_pos = jnp.arange(length).reshape(nb, BLOCK)
    k_pos = (jnp.arange(nb)[:, None] - 1) * BLOCK + jnp.arange(3 * BLOCK)[None, :]
    kp = k_pos[:, None, :]
    in_win = (jnp.abs(q_pos[:, :, None] - kp) <= WINDOW) & (kp >= 0) & (kp < length)
    mask = jnp.concatenate([jnp.ones((nb, BLOCK, n_ctx), bool), in_win], axis=-1)

    def block_fn(args):
        qb, kb, vb, mb = args
        kk = jnp.concatenate([k_ctx, kb], axis=1)
        vv = jnp.concatenate([v_ctx, vb], axis=1)
        return gqa_sink_attend(qb, kk, vv, sink, mb)

    out = lax.map(block_fn, (to_blocks(q), windows(k), windows(v), mask))
    return jnp.swapaxes(out, 0, 1).reshape(b, length, *q.shape[2:])


def hyena_filters(length, w1, b1, w2, b2, w3, b3, freq):
    t = jnp.arange(length, dtype=jnp.float32)
    tn = t / max(length - 1, 1)
    bands = jnp.linspace(1e-4, HYENA_BANDS - 1, HYENA_BANDS, dtype=jnp.float32)
    ang = 2.0 * math.pi * bands[None, :] * t[:, None] / length
    feats = jnp.concatenate([tn[:, None], jnp.cos(ang), -jnp.sin(ang)], axis=-1).astype(w1.dtype)
    hid = jnp.sin(freq * (feats @ w1 + b1))
    hid = jnp.sin(freq * (hid @ w2 + b2))
    h = hid @ w3 + b3
    min_decay = math.log(HYENA_DECAY_TARGET) / HYENA_SLOW_PCT
    max_decay = math.log(HYENA_DECAY_TARGET) / HYENA_FAST_PCT
    deltas = jnp.abs(jnp.linspace(min_decay, max_decay, HYENA_CH, dtype=jnp.float32))
    decay = jnp.exp(-tn[:, None] * deltas[None, :]).astype(h.dtype)
    return h.reshape(length, 2, HYENA_ORDER, HYENA_CH) * decay[:, None, None, :]


def bidir_long_conv(z, h_fwd, h_bwd):
    length, ch = z.shape[1], z.shape[2]
    n = 2 * length
    taps = jnp.concatenate([h_fwd, jnp.zeros((1, ch), h_fwd.dtype), h_bwd[1:][::-1]], axis=0).astype(jnp.float32)
    zf = jnp.fft.rfft(z.astype(jnp.float32), n=n, axis=1)
    tf = jnp.fft.rfft(taps, n=n, axis=0)
    y = jnp.fft.irfft(zf * tf[None], n=n, axis=1)[:, :length]
    return y.astype(z.dtype)


def hyena_mix(u, conv_w, conv_b, filt, bias):
    parts = jnp.split(dwconv3(u, conv_w, conv_b), HYENA_ORDER + 1, axis=-1)
    z = parts[0]
    for n in range(HYENA_ORDER):
        z = parts[n + 1] * (bidir_long_conv(z, filt[:, 0, n], filt[:, 1, n]) + bias[n] * z)
    return z


def conv_ffn(h, w_up, conv_w, conv_b, w_down):
    u = dwconv3(h @ w_up, conv_w, conv_b)
    a, g = jnp.split(u, 2, axis=-1)
    return (jax.nn.silu(g) * a) @ w_down


def even_mixer(h_lat, h_ctx, need_ctx, lambda_init, ropes, w_in, q_norm_g, w_uq, kv_norm_g, w_ukv, diff_lambda, diff_subln_g, w_out):
    def project(h, rope):
        b, length = h.shape[:2]
        cq, ckv, k_rope, dq, dk, dv = split_cols(h @ w_in, EVEN_SPLIT)
        q = (rms_norm(cq, q_norm_g) @ w_uq).reshape(b, length, MLA_HEADS, MLA_NOPE + MLA_ROPE)
        kv = (rms_norm(ckv, kv_norm_g) @ w_ukv).reshape(b, length, MLA_HEADS, MLA_NOPE + MLA_V)
        q_nope, q_rope = q[..., :MLA_NOPE], q[..., MLA_NOPE:]
        k_nope, v_mla = kv[..., :MLA_NOPE], kv[..., MLA_NOPE:]
        dq = dq.reshape(b, length, DIFF_HEADS, 2, DIFF_HEAD_DIM)
        dk = dk.reshape(b, length, DIFF_HEADS, 2, DIFF_HEAD_DIM)
        dv = dv.reshape(b, length, DIFF_HEADS, DIFF_V_DIM)
        if rope is not None:
            (cos_m, sin_m), (cos_d, sin_d) = rope
            q_rope = apply_rope(q_rope, cos_m, sin_m)
            k_rope = apply_rope(k_rope, cos_m, sin_m)
            dq = apply_rope(dq, cos_d, sin_d)
            dk = apply_rope(dk, cos_d, sin_d)
        k_rope = jnp.broadcast_to(k_rope[:, :, None, :], (b, length, MLA_HEADS, MLA_ROPE))
        q_mla = jnp.concatenate([q_nope, q_rope], axis=-1)
        k_mla = jnp.concatenate([k_nope, k_rope], axis=-1)
        return (q_mla, k_mla, v_mla, dq[:, :, :, 0], dq[:, :, :, 1], dk[:, :, :, 0], dk[:, :, :, 1], dv)

    lq1, lk1, lq2, lk2 = diff_lambda.astype(jnp.float32)
    lam = jnp.exp(jnp.sum(lq1 * lk1)) - jnp.exp(jnp.sum(lq2 * lk2)) + lambda_init
    mla_scale = (MLA_NOPE + MLA_ROPE) ** -0.5
    diff_scale = DIFF_HEAD_DIM ** -0.5

    def diff_attend(q1, q2, k1, k2, v):
        return attend(q1, k1, v, diff_scale) - lam.astype(v.dtype) * attend(q2, k2, v, diff_scale)

    def merge(o_mla, o_diff):
        b, length = o_mla.shape[:2]
        o_diff = rms_norm(o_diff, diff_subln_g) * (1.0 - lambda_init)
        return jnp.concatenate([o_mla.reshape(b, length, -1), o_diff.reshape(b, length, -1)], axis=-1) @ w_out

    cq_, ck_, cv_, cdq1, cdq2, cdk1, cdk2, cdv = project(h_ctx, None)
    lq_, lk_, lv_, ldq1, ldq2, ldk1, ldk2, ldv = project(h_lat, ropes)

    def cat(a, b):
        return jnp.concatenate([a, b], axis=1)

    k_all, v_all = cat(ck_, lk_), cat(cv_, lv_)
    dk1_all, dk2_all, dv_all = cat(cdk1, ldk1), cat(cdk2, ldk2), cat(cdv, ldv)
    o_mla = map_query_blocks(lambda qb: attend(qb, k_all, v_all, mla_scale), lq_)
    o_diff = map_query_blocks(lambda q1b, q2b: diff_attend(q1b, q2b, dk1_all, dk2_all, dv_all), ldq1, ldq2)
    y_lat = merge(o_mla, o_diff)
    y_ctx = None
    if need_ctx:
        y_ctx = merge(attend(cq_, ck_, cv_, mla_scale), diff_attend(cdq1, cdq2, cdk1, cdk2, cdv))
    return y_lat, y_ctx


def odd_mixer(h_lat, h_ctx, need_ctx, rope, w_in, sink, conv_w, conv_b, f_w1, f_b1, f_w2, f_b2, f_w3, f_b3, f_freq, hy_bias, w_out):
    sink = sink.reshape(WIN_KV_HEADS, WIN_GROUP)

    def project(h, rope_tab):
        b, length = h.shape[:2]
        q, k, v, u = split_cols(h @ w_in, ODD_SPLIT)
        q = q.reshape(b, length, WIN_KV_HEADS, WIN_GROUP, WIN_HEAD_DIM)
        k = k.reshape(b, length, WIN_KV_HEADS, WIN_HEAD_DIM)
        v = v.reshape(b, length, WIN_KV_HEADS, WIN_HEAD_DIM)
        if rope_tab is not None:
            q = apply_rope(q, *rope_tab)
            k = apply_rope(k, *rope_tab)
        return q, k, v, u

    def hyena(u):
        filt = hyena_filters(u.shape[1], f_w1, f_b1, f_w2, f_b2, f_w3, f_b3, f_freq)
        return hyena_mix(u, conv_w, conv_b, filt, hy_bias)

    def merge(o_win, o_hy):
        b, length = o_win.shape[:2]
        return jnp.concatenate([o_win.reshape(b, length, -1), o_hy], axis=-1) @ w_out

    cq, ck, cv, cu = project(h_ctx, None)
    lq, lk, lv, lu = project(h_lat, rope)
    y_lat = merge(window_attention(lq, lk, lv, ck, cv, sink), hyena(lu))
    y_ctx = None
    if need_ctx:
        y_ctx = merge(gqa_sink_attend(cq, ck, cv, sink, None), hyena(cu))
    return y_lat, y_ctx


def setup_inputs(seed: int = 0) -> dict:
    key = jax.random.key(seed)
    ks = iter(jax.random.split(key, 40))

    def nrm(shape, scale):
        return jax.random.normal(next(ks), shape, jnp.float32) * scale

    def gain(shape):
        return 1.0 + nrm(shape, 0.05)

    return {
        "x": nrm((BATCH, SEQ, D_MODEL), 1.0),
        "c": nrm((BATCH, D_MODEL), 1.0),
        "ctx": nrm((BATCH, CTX_LEN, D_MODEL), 1.0),
        "c_ctx": nrm((D_MODEL,), 1.0),
        "ada_w": nrm((DEPTH, D_MODEL, 6 * D_MODEL), 0.5 * D_MODEL ** -0.5),
        "ada_b": nrm((DEPTH, 6 * D_MODEL), 0.02),
        "norm_g": gain((DEPTH, 4, D_MODEL)),
        "mix_w_out": nrm((DEPTH, MIX_WIDTH, D_MODEL), MIX_WIDTH ** -0.5),
        "ffn_w_up": nrm((DEPTH, D_MODEL, 2 * D_FF), D_MODEL ** -0.5),
        "ffn_conv_w": nrm((DEPTH, 3, 2 * D_FF), 3 ** -0.5),
        "ffn_conv_b": nrm((DEPTH, 2 * D_FF), 0.02),
        "ffn_w_down": nrm((DEPTH, D_FF, D_MODEL), D_FF ** -0.5),
        "even_w_in": nrm((N_EVEN, D_MODEL, EVEN_IN), D_MODEL ** -0.5),
        "mla_q_norm_g": gain((N_EVEN, MLA_Q_RANK)),
        "mla_w_uq": nrm((N_EVEN, MLA_Q_RANK, MLA_HEADS * (MLA_NOPE + MLA_ROPE)), MLA_Q_RANK ** -0.5),
        "mla_kv_norm_g": gain((N_EVEN, MLA_KV_RANK)),
        "mla_w_ukv": nrm((N_EVEN, MLA_KV_RANK, MLA_HEADS * (MLA_NOPE + MLA_V)), MLA_KV_RANK ** -0.5),
        "diff_lambda": nrm((N_EVEN, 4, DIFF_HEAD_DIM), 0.1),
        "diff_subln_g": gain((N_EVEN, DIFF_V_DIM)),
        "odd_w_in": nrm((N_ODD, D_MODEL, ODD_IN), D_MODEL ** -0.5),
        "win_sink": nrm((N_ODD, WIN_Q_HEADS), 0.5),
        "hy_conv_w": nrm((N_ODD, 3, (HYENA_ORDER + 1) * HYENA_CH), 3 ** -0.5),
        "hy_conv_b": nrm((N_ODD, (HYENA_ORDER + 1) * HYENA_CH), 0.02),
        "hy_f_w1": nrm((N_ODD, HYENA_EMB, HYENA_HIDDEN), HYENA_EMB ** -0.5),
        "hy_f_b1": nrm((N_ODD, HYENA_HIDDEN), 0.1),
        "hy_f_w2": nrm((N_ODD, HYENA_HIDDEN, HYENA_HIDDEN), HYENA_HIDDEN ** -0.5),
        "hy_f_b2": nrm((N_ODD, HYENA_HIDDEN), 0.1),
        "hy_f_w3": nrm((N_ODD, HYENA_HIDDEN, 2 * HYENA_ORDER * HYENA_CH), 0.1 * HYENA_HIDDEN ** -0.5),
        "hy_f_b3": nrm((N_ODD, 2 * HYENA_ORDER * HYENA_CH), 0.01),
        "hy_f_freq": 1.0 + nrm((N_ODD, HYENA_HIDDEN), 0.1),
        "hy_bias": nrm((N_ODD, HYENA_ORDER, HYENA_CH), 0.5),
    }


def reference(x, c, ctx, c_ctx, ada_w, ada_b, norm_g, mix_w_out, ffn_w_up, ffn_conv_w, ffn_conv_b, ffn_w_down, even_w_in, mla_q_norm_g, mla_w_uq, mla_kv_norm_g, mla_w_ukv, diff_lambda, diff_subln_g, odd_w_in, win_sink, hy_conv_w, hy_conv_b, hy_f_w1, hy_f_b1, hy_f_w2, hy_f_b2, hy_f_w3, hy_f_b3, hy_f_freq, hy_bias):
    seq = x.shape[1]
    rope_mla = axial_rope(seq, MLA_ROPE)
    rope_diff = axial_rope(seq, DIFF_HEAD_DIM)
    rope_win = axial_rope(seq, WIN_HEAD_DIM)
    sc = jax.nn.silu(c)
    sc_ctx = jax.nn.silu(c_ctx)
    xl, xc = x, ctx
    for layer in range(DEPTH):
        need_ctx = layer < DEPTH - 1
        mod_l = jnp.split((sc @ ada_w[layer] + ada_b[layer])[:, None, :], 6, axis=-1)
        mod_c = jnp.split((sc_ctx @ ada_w[layer] + ada_b[layer])[None, None, :], 6, axis=-1)
        g = norm_g[layer]
        h_l = modulate(rms_norm(xl, g[0]), mod_l[0], mod_l[1])
        h_c = modulate(rms_norm(xc, g[0]), mod_c[0], mod_c[1])
        i = layer // 2
        if layer % 2 == 0:
            lambda_init = 0.8 - 0.6 * math.exp(-0.3 * layer)
            y_l, y_c = even_mixer(h_l, h_c, need_ctx, lambda_init, (rope_mla, rope_diff), even_w_in[i], mla_q_norm_g[i], mla_w_uq[i], mla_kv_norm_g[i], mla_w_ukv[i], diff_lambda[i], diff_subln_g[i], mix_w_out[layer])
        else:
            y_l, y_c = odd_mixer(h_l, h_c, need_ctx, rope_win, odd_w_in[i], win_sink[i], hy_conv_w[i], hy_conv_b[i], hy_f_w1[i], hy_f_b1[i], hy_f_w2[i], hy_f_b2[i], hy_f_w3[i], hy_f_b3[i], hy_f_freq[i], hy_bias[i], mix_w_out[layer])
        ffn_args = (ffn_w_up[layer], ffn_conv_w[layer], ffn_conv_b[layer], ffn_w_down[layer])
        xl = xl + mod_l[2] * rms_norm(y_l, g[1])
        h_l = modulate(rms_norm(xl, g[2]), mod_l[3], mod_l[4])
        xl = xl + mod_l[5] * rms_norm(conv_ffn(h_l, *ffn_args), g[3])
        if need_ctx:
            xc = xc + mod_c[2] * rms_norm(y_c, g[1])
            h_c2 = modulate(rms_norm(xc, g[2]), mod_c[3], mod_c[4])
            xc = xc + mod_c[5] * rms_norm(conv_ffn(h_c2, *ffn_args), g[3])
    return xl
```

```cpp
#include <hip/hip_runtime.h>
#include <hip/hip_cooperative_groups.h>
#include <stdint.h>
#include <stdio.h>
namespace cg = cooperative_groups;


#ifndef MULTI_LAUNCH
#define MULTI_LAUNCH 0
#endif

#define DI __device__ __forceinline__
#define GAS __attribute__((address_space(1)))
#define LAS __attribute__((address_space(3)))
typedef unsigned short bf16_t;
typedef short bf16x8 __attribute__((ext_vector_type(8)));
typedef short s16x4 __attribute__((ext_vector_type(4)));
typedef float f32x16 __attribute__((ext_vector_type(16)));
typedef float f32x4 __attribute__((ext_vector_type(4)));
typedef float f32x2 __attribute__((ext_vector_type(2)));
typedef unsigned u32x4 __attribute__((ext_vector_type(4)));
typedef unsigned u32x2 __attribute__((ext_vector_type(2)));
typedef __bf16 bf2_t __attribute__((ext_vector_type(2)));

constexpr int NL = 65536, NC = 8192, NT = NL + NC;
constexpr int SMEM_BYTES = 76800;
constexpr int NPH = 24;
constexpr int PLD = 2304;
constexpr int PE_CQ = 0, PE_CKV = 384, PE_DQ = 640, PE_DK = 1152, PE_DV = 1664, PE_KR = 2176;

constexpr size_t OFF_WT_IN0 = 0;
constexpr size_t OFF_WT_UQ  = OFF_WT_IN0 + 4718592;
constexpr size_t OFF_WT_UKV = OFF_WT_UQ + 589824;
constexpr size_t OFF_WT_OUT0 = OFF_WT_UKV + 524288;
constexpr size_t OFF_WT_OUT1 = OFF_WT_OUT0 + 2097152;
constexpr size_t OFF_WT_UP0 = OFF_WT_OUT1 + 2097152;
constexpr size_t OFF_WT_UP1 = OFF_WT_UP0 + 11534336;
constexpr size_t OFF_WT_DN0 = OFF_WT_UP1 + 11534336;
constexpr size_t OFF_WT_DN1 = OFF_WT_DN0 + 5767168;
constexpr size_t OFF_WT_IN1 = OFF_WT_DN1 + 5767168;
constexpr size_t OFF_MOD = OFF_WT_IN1 + 4718592;
constexpr size_t MOD_BYTES = 2 * 33 * 6144 * 4;
constexpr size_t OFF_BAR = OFF_MOD + MOD_BYTES;
constexpr size_t BAR_BYTES = 13824;
constexpr size_t OFF_CS64 = OFF_BAR + BAR_BYTES;
constexpr size_t OFF_CS32 = OFF_CS64 + 524288;
constexpr size_t OFF_GARR = OFF_CS32 + 262144;
constexpr size_t OFF_XC = OFF_GARR + 8388608 + 4096;
constexpr size_t OFF_H = OFF_XC + 33554432;
constexpr size_t OFF_P = OFF_H + 150994944;
constexpr size_t OFF_Q = OFF_P + 339738624;
constexpr size_t OFF_KV = OFF_Q + 113246208;
constexpr size_t OFF_MI = OFF_KV + 150994944;
constexpr size_t WS_END = OFF_MI + 150994944;
static_assert(WS_END <= (size_t)1073741824, "workspace");
constexpr size_t OFF_Y = OFF_KV;
constexpr size_t OFF_G = OFF_P;
constexpr size_t OFF_BND = OFF_MI;
constexpr size_t OFF_HT = OFF_Q;
constexpr size_t OFF_Z1T = OFF_H;
constexpr size_t OFF_Z2T = OFF_H + 67108864;

struct Params { const float* in[31]; float* out; char* ws; int ph_lo, ph_hi; };
typedef const __attribute__((address_space(4))) Params KParams;

DI unsigned pk2(float a, float b) { f32x2 v = {a, b}; bf2_t r = __builtin_convertvector(v, bf2_t); return __builtin_bit_cast(unsigned, r); }
DI float bflo(unsigned w) { return __uint_as_float(w << 16); }
DI float bfhi(unsigned w) { return __uint_as_float(w & 0xffff0000u); }
DI float bf2f(unsigned short v) { return __uint_as_float(((unsigned)v) << 16); }
DI unsigned short f2bf(float x) { return (unsigned short)(pk2(x, 0.f) & 0xffffu); }
DI float wave_sum(float v) {
#pragma unroll
  for (int o = 32; o > 0; o >>= 1) v += __shfl_xor(v, o);
  return v;
}
DI float siluf(float v) { return v / (1.f + __expf(-v)); }
DI f32x16 mfma32(bf16x8 a, bf16x8 b, f32x16 c) { return __builtin_amdgcn_mfma_f32_32x32x16_bf16(a, b, c, 0, 0, 0); }
DI int crow(int reg, int h) { return (reg & 3) + 8 * (reg >> 2) + 4 * h; }

DI void gemm_tile_to_lds(const bf16_t* __restrict__ A, int lda, const bf16_t* __restrict__ Bt, int K, int m0, int n0, char* smem, int tid) {
  const int lane = tid & 63, wid = tid >> 6, wr = wid >> 1, wc = wid & 1;
  const int srow = tid >> 3, sc = tid & 7;
  const bf16_t* ap = A + (size_t)(m0 + srow) * lda + sc * 8;
  const bf16_t* bp = Bt + (size_t)(n0 + srow) * K + sc * 8;
  const size_t astep = (size_t)32 * lda, bstep = (size_t)32 * K;
  const int st_off = srow * 144 + sc * 16;
  const int a_rd = (wr * 64 + (lane & 31)) * 144 + (lane >> 5) * 16;
  const int b_rd = 18432 + (wc * 64 + (lane & 31)) * 144 + (lane >> 5) * 16;
  f32x16 acc[2][2];
#pragma unroll
  for (int i = 0; i < 2; ++i)
#pragma unroll
    for (int j = 0; j < 2; ++j)
#pragma unroll
      for (int e = 0; e < 16; ++e) acc[i][j][e] = 0.f;
  u32x4 ra0[4], rb0[4], ra1[4], rb1[4];
  const int nk = K >> 6;
#pragma unroll
  for (int i = 0; i < 4; ++i) { ra0[i] = *(const GAS u32x4*)(ap + i * astep); rb0[i] = *(const GAS u32x4*)(bp + i * bstep); }
#pragma unroll
  for (int i = 0; i < 4; ++i) { ra1[i] = *(const GAS u32x4*)(ap + i * astep + 64); rb1[i] = *(const GAS u32x4*)(bp + i * bstep + 64); }
#pragma unroll
  for (int i = 0; i < 4; ++i) { *(u32x4*)(smem + st_off + i * 4608) = ra0[i]; *(u32x4*)(smem + 18432 + st_off + i * 4608) = rb0[i]; }
  __syncthreads();
#define GEMM_STEP(CUR, NXT, RL_A, RL_B, RS_A, RS_B, KLOAD) do { \
    const int kl_ = ((KLOAD) < nk) ? (KLOAD) : (nk - 1); \
    _Pragma("unroll") for (int i = 0; i < 4; ++i) { RL_A[i] = *(const GAS u32x4*)(ap + i * astep + kl_ * 64); RL_B[i] = *(const GAS u32x4*)(bp + i * bstep + kl_ * 64); } \
    bf16x8 af[4][2], bfr[4][2]; \
    _Pragma("unroll") for (int kk = 0; kk < 4; ++kk) { \
      af[kk][0] = *(const bf16x8*)((CUR) + a_rd + kk * 32); af[kk][1] = *(const bf16x8*)((CUR) + a_rd + 4608 + kk * 32); \
      bfr[kk][0] = *(const bf16x8*)((CUR) + b_rd + kk * 32); bfr[kk][1] = *(const bf16x8*)((CUR) + b_rd + 4608 + kk * 32); } \
    _Pragma("unroll") for (int kk = 0; kk < 4; ++kk) { \
      acc[0][0] = mfma32(af[kk][0], bfr[kk][0], acc[0][0]); acc[0][1] = mfma32(af[kk][0], bfr[kk][1], acc[0][1]); \
      acc[1][0] = mfma32(af[kk][1], bfr[kk][0], acc[1][0]); acc[1][1] = mfma32(af[kk][1], bfr[kk][1], acc[1][1]); } \
    _Pragma("unroll") for (int i = 0; i < 4; ++i) { *(u32x4*)((NXT) + st_off + i * 4608) = RS_A[i]; *(u32x4*)((NXT) + 18432 + st_off + i * 4608) = RS_B[i]; } \
    __builtin_amdgcn_sched_group_barrier(0x020, 8, 0); \
    __builtin_amdgcn_sched_group_barrier(0x100, 4, 0); \
    _Pragma("unroll") for (int q = 0; q < 12; ++q) { __builtin_amdgcn_sched_group_barrier(0x008, 1, 0); __builtin_amdgcn_sched_group_barrier(0x100, 1, 0); } \
    __builtin_amdgcn_sched_group_barrier(0x008, 4, 0); \
    __builtin_amdgcn_sched_group_barrier(0x200, 8, 0); \
    __syncthreads(); } while (0)
  for (int kt = 0; kt < nk; kt += 2) {
    GEMM_STEP(smem, smem + 36864, ra0, rb0, ra1, rb1, kt + 2);
    GEMM_STEP(smem + 36864, smem, ra1, rb1, ra0, rb0, kt + 3);
  }
#undef GEMM_STEP
  float* Cs = (float*)smem;
  const int h = lane >> 5, cl = lane & 31;
#pragma unroll
  for (int i = 0; i < 2; ++i)
#pragma unroll
    for (int j = 0; j < 2; ++j)
#pragma unroll
      for (int e = 0; e < 16; ++e) Cs[(wr * 64 + i * 32 + crow(e, h)) * 132 + wc * 64 + j * 32 + cl] = acc[i][j][e];
  __syncthreads();
}

DI void epi_bf16(const char* smem, bf16_t* __restrict__ out, int ldo, int m0, int n0, int tid) {
  const float* Cs = (const float*)smem;
#pragma unroll
  for (int i = 0; i < 8; ++i) {
    const int id = tid + 256 * i, r = id >> 4, c8 = (id & 15) * 8;
    const f32x4 v0 = *(const f32x4*)(Cs + r * 132 + c8), v1 = *(const f32x4*)(Cs + r * 132 + c8 + 4);
    u32x4 w; w.x = pk2(v0[0], v0[1]); w.y = pk2(v0[2], v0[3]); w.z = pk2(v1[0], v1[1]); w.w = pk2(v1[2], v1[3]);
    *(GAS u32x4*)(out + (size_t)(m0 + r) * ldo + n0 + c8) = w;
  }
  __syncthreads();
}

DI void epi_ffn(const char* smem, bf16_t* __restrict__ G, float* __restrict__ BND, const float* __restrict__ cw, const float* __restrict__ cb, int mt, int nt, int tid) {
  const float* Cs = (const float*)smem;
  const int m0 = mt * 128;
  const int L = (mt < 512) ? 2048 : 256;
  const bool first = (m0 % L) == 0, last = ((m0 + 128) % L) == 0;
  const int ja0 = nt * 64;
#pragma unroll
  for (int i = 0; i < 4; ++i) {
    const int id = tid + 256 * i, r = id >> 3, j8 = (id & 7) * 8;
    const bool top = (r == 0), bot = (r == 127);
    if ((top && !first) || (bot && !last)) continue;
    float res[8];
#pragma unroll
    for (int hh = 0; hh < 2; ++hh) {
      const int ja = ja0 + j8 + hh * 4;
      const f32x4 z4 = {0.f, 0.f, 0.f, 0.f};
      const int ca = j8 + hh * 4, cg_ = 64 + j8 + hh * 4;
      f32x4 ua, ug;
      {
        const f32x4 w0 = *(const GAS f32x4*)(cw + ja), w1 = *(const GAS f32x4*)(cw + 5632 + ja), w2 = *(const GAS f32x4*)(cw + 11264 + ja), bb = *(const GAS f32x4*)(cb + ja);
        const f32x4 pv = top ? z4 : *(const f32x4*)(Cs + (r - 1) * 132 + ca), cu = *(const f32x4*)(Cs + r * 132 + ca), nx = bot ? z4 : *(const f32x4*)(Cs + (r + 1) * 132 + ca);
        ua = w0 * pv + w1 * cu + w2 * nx + bb;
      }
      __builtin_amdgcn_sched_barrier(0);
      {
        const f32x4 w0 = *(const GAS f32x4*)(cw + 2816 + ja), w1 = *(const GAS f32x4*)(cw + 5632 + 2816 + ja), w2 = *(const GAS f32x4*)(cw + 11264 + 2816 + ja), bb = *(const GAS f32x4*)(cb + 2816 + ja);
        const f32x4 pv = top ? z4 : *(const f32x4*)(Cs + (r - 1) * 132 + cg_), cu = *(const f32x4*)(Cs + r * 132 + cg_), nx = bot ? z4 : *(const f32x4*)(Cs + (r + 1) * 132 + cg_);
        ug = w0 * pv + w1 * cu + w2 * nx + bb;
      }
#pragma unroll
      for (int e = 0; e < 4; ++e) res[hh * 4 + e] = siluf(ug[e]) * ua[e];
      __builtin_amdgcn_sched_barrier(0);
    }
    u32x4 w; w.x = pk2(res[0], res[1]); w.y = pk2(res[2], res[3]); w.z = pk2(res[4], res[5]); w.w = pk2(res[6], res[7]);
    *(GAS u32x4*)(G + (size_t)(m0 + r) * 2816 + ja0 + j8) = w;
  }
  if (tid < 128) {
    const int q = tid >> 5, c4 = (tid & 31) * 4;
    const int r = (q == 0) ? 0 : (q == 1) ? 1 : (q == 2) ? 126 : 127;
    const f32x4 v = *(const f32x4*)(Cs + r * 132 + c4);
    *(GAS f32x4*)(BND + ((size_t)(mt * 4 + q)) * 5632 + nt * 128 + c4) = v;
  }
  __syncthreads();
}

struct EpiArgs { bf16_t* out; int ldo; float* bnd; const float* cw; const float* cb; };
template <int EPI, int VAR = 0>
DI void gemm_tile256(const bf16_t* __restrict__ A, int lda, const bf16_t* __restrict__ Bt, int K, int mt, int nt, char* smem, int tid_in, const EpiArgs& ea) {
  int tid = tid_in; asm volatile("" : "+v"(tid));
  const int lane = tid & 63, wid = __builtin_amdgcn_readfirstlane(tid >> 6), wr = wid >> 1, wc = wid & 1;
  const int m0 = mt * 128, n0 = nt * 256;
  const int r = lane & 31, h = lane >> 5, key = (r >> 2) & 3;
  constexpr int STG = 24576;
  const int rowl = lane >> 2, cch = (lane & 3) ^ ((lane >> 4) & 3);
  const unsigned voffA = (unsigned)(rowl * lda * 2 + cch * 16), voffB = (unsigned)(rowl * K * 2 + cch * 16);
  const char* Abase = (const char*)(A + (size_t)m0 * lda) + (size_t)(wid * 2) * 32 * lda;
  const char* Bbase = (const char*)(Bt + (size_t)n0 * K) + (size_t)(wid * 4) * 32 * K;
  const size_t ablk = (size_t)32 * lda, bblk = (size_t)32 * K;
  LAS char* lds = (LAS char*)smem;
  LAS char* ldsA = lds + (wid * 2) * 1024;
  LAS char* ldsB = lds + 8192 + (wid * 4) * 1024;
#define DMA_STEP_(k, soff) do { \
    _Pragma("unroll") for (int q_ = 0; q_ < 2; ++q_) __builtin_amdgcn_global_load_lds((const GAS unsigned*)(Abase + q_ * ablk + (size_t)(k) * 64 + voffA), (LAS unsigned*)(ldsA + (soff) + q_ * 1024), 16, 0, 0); \
    _Pragma("unroll") for (int q_ = 0; q_ < 4; ++q_) __builtin_amdgcn_global_load_lds((const GAS unsigned*)(Bbase + q_ * bblk + (size_t)(k) * 64 + voffB), (LAS unsigned*)(ldsB + (soff) + q_ * 1024), 16, 0, 0); } while (0)
  const int x0 = ((0 + h) ^ key) * 16, x1 = ((2 + h) ^ key) * 16;
  const int a_rd = (wr * 64 + r) * 64, b_rd = 8192 + (wc * 128 + r) * 64;
  f32x16 acc[2][4];
#pragma unroll
  for (int i = 0; i < 2; ++i)
#pragma unroll
    for (int j = 0; j < 4; ++j)
#pragma unroll
      for (int e = 0; e < 16; ++e) acc[i][j][e] = 0.f;
  const int nk = K >> 5;
  DMA_STEP_(0, 0);
  DMA_STEP_(1, STG);
  asm volatile("s_waitcnt vmcnt(6)" ::: "memory");
  __builtin_amdgcn_s_barrier();
  asm volatile("" ::: "memory");
  int s0 = 0, s2 = 2 * STG;
  for (int kt = 0; kt < nk; ++kt) {
    const int kn = (kt + 2 < nk) ? (kt + 2) : (nk - 1);
    const LAS char* cur = lds + s0;
    bf16x8 af[2][2], bfr[2][4];
#pragma unroll
    for (int kk = 0; kk < 2; ++kk) {
      const int xo = kk ? x1 : x0;
      af[kk][0] = *(const LAS bf16x8*)(cur + a_rd + xo);
      bfr[kk][0] = *(const LAS bf16x8*)(cur + b_rd + xo);
      bfr[kk][1] = *(const LAS bf16x8*)(cur + b_rd + 2048 + xo);
      af[kk][1] = *(const LAS bf16x8*)(cur + a_rd + 2048 + xo);
      bfr[kk][2] = *(const LAS bf16x8*)(cur + b_rd + 4096 + xo);
      bfr[kk][3] = *(const LAS bf16x8*)(cur + b_rd + 6144 + xo);
    }
    DMA_STEP_(kn, s2);
#pragma unroll
    for (int kk = 0; kk < 2; ++kk) {
      acc[0][0] = mfma32(bfr[kk][0], af[kk][0], acc[0][0]); acc[0][1] = mfma32(bfr[kk][1], af[kk][0], acc[0][1]);
      acc[1][0] = mfma32(bfr[kk][0], af[kk][1], acc[1][0]); acc[1][1] = mfma32(bfr[kk][1], af[kk][1], acc[1][1]);
      acc[0][2] = mfma32(bfr[kk][2], af[kk][0], acc[0][2]); acc[0][3] = mfma32(bfr[kk][3], af[kk][0], acc[0][3]);
      acc[1][2] = mfma32(bfr[kk][2], af[kk][1], acc[1][2]); acc[1][3] = mfma32(bfr[kk][3], af[kk][1], acc[1][3]);
    }
    __builtin_amdgcn_sched_group_barrier(0x100, 12, 0);
    __builtin_amdgcn_sched_group_barrier(0x010, 6, 0);
    __builtin_amdgcn_sched_group_barrier(0x008, 16, 0);
    asm volatile("s_waitcnt vmcnt(6) lgkmcnt(0)" ::: "memory");
    __builtin_amdgcn_s_barrier();
    asm volatile("" ::: "memory");
    s0 = (s0 == 2 * STG) ? 0 : s0 + STG;
    s2 = (s2 == 2 * STG) ? 0 : s2 + STG;
  }
  asm volatile("s_waitcnt vmcnt(0)" ::: "memory");
  __builtin_amdgcn_s_barrier();
  asm volatile("" ::: "memory");
#undef DMA_STEP_
  {
    const int h = lane >> 5, cl = lane & 31;
#pragma unroll
    for (int i = 0; i < 2; ++i)
#pragma unroll
      for (int j = 0; j < 4; ++j)
#pragma unroll
        for (int g = 0; g < 4; ++g) {
          u32x2 w; w.x = pk2(acc[i][j][4 * g], acc[i][j][4 * g + 1]); w.y = pk2(acc[i][j][4 * g + 2], acc[i][j][4 * g + 3]);
          *(u32x2*)(smem + (wr * 64 + i * 32 + cl) * 528 + (wc * 128 + j * 32 + 8 * g + 4 * h) * 2) = w;
        }
  }
  __syncthreads();
  int tid2 = tid; asm volatile("" : "+v"(tid2));
  if (EPI == 0) {
#pragma unroll
    for (int i = 0; i < 16; ++i) {
      const int id = tid2 + 256 * i, r = id >> 5, c8 = (id & 31) * 8;
      const u32x4 v = *(const u32x4*)(smem + r * 528 + c8 * 2);
      *(GAS u32x4*)(ea.out + (size_t)(m0 + r) * ea.ldo + n0 + c8) = v;
    }
  } else {
    const int L = (mt < 512) ? 2048 : 256;
    const bool first = (m0 % L) == 0, last = ((m0 + 128) % L) == 0;
    const float* cw = ea.cw; const float* cb = ea.cb;
#pragma unroll 1
    for (int p = 0; p < 2; ++p) {
      const int j8 = (tid2 & 7) * 8;
      const int ja0 = (nt * 2 + p) * 64, ja = ja0 + j8;
      f32x4 wa[4][2], wg[4][2];
#pragma unroll
      for (int hh = 0; hh < 2; ++hh) {
        wa[0][hh] = *(const GAS f32x4*)(cw + ja + 4 * hh); wa[1][hh] = *(const GAS f32x4*)(cw + 5632 + ja + 4 * hh); wa[2][hh] = *(const GAS f32x4*)(cw + 11264 + ja + 4 * hh); wa[3][hh] = *(const GAS f32x4*)(cb + ja + 4 * hh);
        wg[0][hh] = *(const GAS f32x4*)(cw + 2816 + ja + 4 * hh); wg[1][hh] = *(const GAS f32x4*)(cw + 5632 + 2816 + ja + 4 * hh); wg[2][hh] = *(const GAS f32x4*)(cw + 11264 + 2816 + ja + 4 * hh); wg[3][hh] = *(const GAS f32x4*)(cb + 2816 + ja + 4 * hh);
      }
#pragma unroll 1
      for (int i = 0; i < 4; ++i) {
        const int r = (tid2 + 256 * i) >> 3;
        const bool top = (r == 0), bot = (r == 127);
        if ((top && !first) || (bot && !last)) continue;
        const char* base = smem + r * 528 + (p * 128 + j8) * 2;
        const u32x4 zz = {0u, 0u, 0u, 0u};
        const u32x4 pa = top ? zz : *(const u32x4*)(base - 528), ca = *(const u32x4*)base, na = bot ? zz : *(const u32x4*)(base + 528);
        const u32x4 pg = top ? zz : *(const u32x4*)(base - 528 + 128), cg = *(const u32x4*)(base + 128), ng = bot ? zz : *(const u32x4*)(base + 528 + 128);
        unsigned resw[4];
#pragma unroll
        for (int q = 0; q < 4; ++q) {
          const int hh = q >> 1, e0 = (q & 1) * 2;
          const float ua0 = wa[0][hh][e0] * bflo(pa[q]) + wa[1][hh][e0] * bflo(ca[q]) + wa[2][hh][e0] * bflo(na[q]) + wa[3][hh][e0];
          const float ua1 = wa[0][hh][e0 + 1] * bfhi(pa[q]) + wa[1][hh][e0 + 1] * bfhi(ca[q]) + wa[2][hh][e0 + 1] * bfhi(na[q]) + wa[3][hh][e0 + 1];
          const float ug0 = wg[0][hh][e0] * bflo(pg[q]) + wg[1][hh][e0] * bflo(cg[q]) + wg[2][hh][e0] * bflo(ng[q]) + wg[3][hh][e0];
          const float ug1 = wg[0][hh][e0 + 1] * bfhi(pg[q]) + wg[1][hh][e0 + 1] * bfhi(cg[q]) + wg[2][hh][e0 + 1] * bfhi(ng[q]) + wg[3][hh][e0 + 1];
          resw[q] = pk2(siluf(ug0) * ua0, siluf(ug1) * ua1);
        }
        u32x4 w; w.x = resw[0]; w.y = resw[1]; w.z = resw[2]; w.w = resw[3];
        __builtin_nontemporal_store(w, (GAS u32x4*)(ea.out + (size_t)(m0 + r) * 2816 + ja0 + j8));
      }
    }
    {
      const int q = tid2 >> 6, c4 = (tid2 & 63) * 4;
      const int r = (q == 0) ? 0 : (q == 1) ? 1 : (q == 2) ? 126 : 127;
      const u32x2 v = *(const u32x2*)(smem + r * 528 + c4 * 2);
      const f32x4 o = {bflo(v.x), bfhi(v.x), bflo(v.y), bfhi(v.y)};
      __builtin_nontemporal_store(o, (GAS f32x4*)(ea.bnd + ((size_t)(mt * 4 + q)) * 5632 + nt * 256 + c4));
    }
  }
  __syncthreads();
}

#define TRV_OUTS(R) "=&v"(R[0]), "=&v"(R[1]), "=&v"(R[2]), "=&v"(R[3]), "=&v"(R[4]), "=&v"(R[5]), "=&v"(R[6]), "=&v"(R[7]), "=&v"(R[8]), "=&v"(R[9]), "=&v"(R[10]), "=&v"(R[11]), "=&v"(R[12]), "=&v"(R[13]), "=&v"(R[14]), "=&v"(R[15])
#define TRV_OUTS8(R) "=&v"(R[0]), "=&v"(R[1]), "=&v"(R[2]), "=&v"(R[3]), "=&v"(R[4]), "=&v"(R[5]), "=&v"(R[6]), "=&v"(R[7])
#define TRV8_320_T0(R, addr) asm volatile( \
    "ds_read_b64_tr_b16 %0, %8 offset:0\n\t" \
    "ds_read_b64_tr_b16 %1, %8 offset:2560\n\t" \
    "ds_read_b64_tr_b16 %2, %8 offset:5120\n\t" \
    "ds_read_b64_tr_b16 %3, %8 offset:7680\n\t" \
    "ds_read_b64_tr_b16 %4, %8 offset:10240\n\t" \
    "ds_read_b64_tr_b16 %5, %8 offset:12800\n\t" \
    "ds_read_b64_tr_b16 %6, %8 offset:15360\n\t" \
    "ds_read_b64_tr_b16 %7, %8 offset:17920\n\t" \
    "s_waitcnt lgkmcnt(0)" : TRV_OUTS8(R) : "v"(addr) : "memory")
#define TRV8_320_T1(R, addr) asm volatile( \
    "ds_read_b64_tr_b16 %0, %8 offset:64\n\t" \
    "ds_read_b64_tr_b16 %1, %8 offset:2624\n\t" \
    "ds_read_b64_tr_b16 %2, %8 offset:5184\n\t" \
    "ds_read_b64_tr_b16 %3, %8 offset:7744\n\t" \
    "ds_read_b64_tr_b16 %4, %8 offset:10304\n\t" \
    "ds_read_b64_tr_b16 %5, %8 offset:12864\n\t" \
    "ds_read_b64_tr_b16 %6, %8 offset:15424\n\t" \
    "ds_read_b64_tr_b16 %7, %8 offset:17984\n\t" \
    "s_waitcnt lgkmcnt(0)" : TRV_OUTS8(R) : "v"(addr) : "memory")
#define TRV8_320_T2(R, addr) asm volatile( \
    "ds_read_b64_tr_b16 %0, %8 offset:128\n\t" \
    "ds_read_b64_tr_b16 %1, %8 offset:2688\n\t" \
    "ds_read_b64_tr_b16 %2, %8 offset:5248\n\t" \
    "ds_read_b64_tr_b16 %3, %8 offset:7808\n\t" \
    "ds_read_b64_tr_b16 %4, %8 offset:10368\n\t" \
    "ds_read_b64_tr_b16 %5, %8 offset:12928\n\t" \
    "ds_read_b64_tr_b16 %6, %8 offset:15488\n\t" \
    "ds_read_b64_tr_b16 %7, %8 offset:18048\n\t" \
    "s_waitcnt lgkmcnt(0)" : TRV_OUTS8(R) : "v"(addr) : "memory")
#define TRV8_320_T3(R, addr) asm volatile( \
    "ds_read_b64_tr_b16 %0, %8 offset:192\n\t" \
    "ds_read_b64_tr_b16 %1, %8 offset:2752\n\t" \
    "ds_read_b64_tr_b16 %2, %8 offset:5312\n\t" \
    "ds_read_b64_tr_b16 %3, %8 offset:7872\n\t" \
    "ds_read_b64_tr_b16 %4, %8 offset:10432\n\t" \
    "ds_read_b64_tr_b16 %5, %8 offset:12992\n\t" \
    "ds_read_b64_tr_b16 %6, %8 offset:15552\n\t" \
    "ds_read_b64_tr_b16 %7, %8 offset:18112\n\t" \
    "s_waitcnt lgkmcnt(0)" : TRV_OUTS8(R) : "v"(addr) : "memory")
#define TRV8_192_T0(R, addr) asm volatile( \
    "ds_read_b64_tr_b16 %0, %8 offset:0\n\t" \
    "ds_read_b64_tr_b16 %1, %8 offset:1536\n\t" \
    "ds_read_b64_tr_b16 %2, %8 offset:3072\n\t" \
    "ds_read_b64_tr_b16 %3, %8 offset:4608\n\t" \
    "ds_read_b64_tr_b16 %4, %8 offset:6144\n\t" \
    "ds_read_b64_tr_b16 %5, %8 offset:7680\n\t" \
    "ds_read_b64_tr_b16 %6, %8 offset:9216\n\t" \
    "ds_read_b64_tr_b16 %7, %8 offset:10752\n\t" \
    "s_waitcnt lgkmcnt(0)" : TRV_OUTS8(R) : "v"(addr) : "memory")
#define TRV8_192_T1(R, addr) asm volatile( \
    "ds_read_b64_tr_b16 %0, %8 offset:64\n\t" \
    "ds_read_b64_tr_b16 %1, %8 offset:1600\n\t" \
    "ds_read_b64_tr_b16 %2, %8 offset:3136\n\t" \
    "ds_read_b64_tr_b16 %3, %8 offset:4672\n\t" \
    "ds_read_b64_tr_b16 %4, %8 offset:6208\n\t" \
    "ds_read_b64_tr_b16 %5, %8 offset:7744\n\t" \
    "ds_read_b64_tr_b16 %6, %8 offset:9280\n\t" \
    "ds_read_b64_tr_b16 %7, %8 offset:10816\n\t" \
    "s_waitcnt lgkmcnt(0)" : TRV_OUTS8(R) : "v"(addr) : "memory")
#define TRV_READ_192_T0(R, addr) asm volatile( \
    "ds_read_b64_tr_b16 %0, %16 offset:0\n\t" \
    "ds_read_b64_tr_b16 %1, %16 offset:1536\n\t" \
    "ds_read_b64_tr_b16 %2, %16 offset:3072\n\t" \
    "ds_read_b64_tr_b16 %3, %16 offset:4608\n\t" \
    "ds_read_b64_tr_b16 %4, %16 offset:6144\n\t" \
    "ds_read_b64_tr_b16 %5, %16 offset:7680\n\t" \
    "ds_read_b64_tr_b16 %6, %16 offset:9216\n\t" \
    "ds_read_b64_tr_b16 %7, %16 offset:10752\n\t" \
    "ds_read_b64_tr_b16 %8, %16 offset:64\n\t" \
    "ds_read_b64_tr_b16 %9, %16 offset:1600\n\t" \
    "ds_read_b64_tr_b16 %10, %16 offset:3136\n\t" \
    "ds_read_b64_tr_b16 %11, %16 offset:4672\n\t" \
    "ds_read_b64_tr_b16 %12, %16 offset:6208\n\t" \
    "ds_read_b64_tr_b16 %13, %16 offset:7744\n\t" \
    "ds_read_b64_tr_b16 %14, %16 offset:9280\n\t" \
    "ds_read_b64_tr_b16 %15, %16 offset:10816\n\t" \
    "s_waitcnt lgkmcnt(0)" : TRV_OUTS(R) : "v"(addr) : "memory")
#define TRV_READ_320_T0(R, addr) asm volatile( \
    "ds_read_b64_tr_b16 %0, %16 offset:0\n\t" \
    "ds_read_b64_tr_b16 %1, %16 offset:2560\n\t" \
    "ds_read_b64_tr_b16 %2, %16 offset:5120\n\t" \
    "ds_read_b64_tr_b16 %3, %16 offset:7680\n\t" \
    "ds_read_b64_tr_b16 %4, %16 offset:10240\n\t" \
    "ds_read_b64_tr_b16 %5, %16 offset:12800\n\t" \
    "ds_read_b64_tr_b16 %6, %16 offset:15360\n\t" \
    "ds_read_b64_tr_b16 %7, %16 offset:17920\n\t" \
    "ds_read_b64_tr_b16 %8, %16 offset:64\n\t" \
    "ds_read_b64_tr_b16 %9, %16 offset:2624\n\t" \
    "ds_read_b64_tr_b16 %10, %16 offset:5184\n\t" \
    "ds_read_b64_tr_b16 %11, %16 offset:7744\n\t" \
    "ds_read_b64_tr_b16 %12, %16 offset:10304\n\t" \
    "ds_read_b64_tr_b16 %13, %16 offset:12864\n\t" \
    "ds_read_b64_tr_b16 %14, %16 offset:15424\n\t" \
    "ds_read_b64_tr_b16 %15, %16 offset:17984\n\t" \
    "s_waitcnt lgkmcnt(0)" : TRV_OUTS(R) : "v"(addr) : "memory")
#define TRV_READ_320_T2(R, addr) asm volatile( \
    "ds_read_b64_tr_b16 %0, %16 offset:128\n\t" \
    "ds_read_b64_tr_b16 %1, %16 offset:2688\n\t" \
    "ds_read_b64_tr_b16 %2, %16 offset:5248\n\t" \
    "ds_read_b64_tr_b16 %3, %16 offset:7808\n\t" \
    "ds_read_b64_tr_b16 %4, %16 offset:10368\n\t" \
    "ds_read_b64_tr_b16 %5, %16 offset:12928\n\t" \
    "ds_read_b64_tr_b16 %6, %16 offset:15488\n\t" \
    "ds_read_b64_tr_b16 %7, %16 offset:18048\n\t" \
    "ds_read_b64_tr_b16 %8, %16 offset:192\n\t" \
    "ds_read_b64_tr_b16 %9, %16 offset:2752\n\t" \
    "ds_read_b64_tr_b16 %10, %16 offset:5312\n\t" \
    "ds_read_b64_tr_b16 %11, %16 offset:7872\n\t" \
    "ds_read_b64_tr_b16 %12, %16 offset:10432\n\t" \
    "ds_read_b64_tr_b16 %13, %16 offset:12992\n\t" \
    "ds_read_b64_tr_b16 %14, %16 offset:15552\n\t" \
    "ds_read_b64_tr_b16 %15, %16 offset:18112\n\t" \
    "s_waitcnt lgkmcnt(0)" : TRV_OUTS(R) : "v"(addr) : "memory")

template <int MODE> DI int key_tile_row(int i, int b, int qn, int wlo) {
  if (i < 4) return NL + b * 256 + 64 * i;
  if (MODE == 0) return b * 2048 + 64 * (i - 4);
  return b * 2048 + (qn - 1) * 128 + 64 * (wlo + i - 4);
}

template <int DQK, int DV, int KW0, int WHICH>
DI void attn_gload(u32x4 (&kreg)[(64 * (DQK / 8)) / 256], u32x4 (&vreg)[(32 * (DV / 8)) / 256][2],
                   const bf16_t* __restrict__ k0p, int ldk0, const bf16_t* __restrict__ k1p, int ldk1, const bf16_t* __restrict__ vp, int ldv, int krow, int tid) {
  constexpr int KCH = DQK / 8, NKC = (64 * KCH) / 256, VCH = DV / 8, NVU = (32 * VCH) / 256;
  if (WHICH & 1)
#pragma unroll
  for (int i = 0; i < NKC; ++i) {
    const int id = tid + 256 * i, key = id / KCH, ch = id % KCH;
    const bf16_t* src;
    if constexpr (KW0 == DQK) src = (const bf16_t*)((const char*)(k0p + (size_t)krow * ldk0) + (unsigned)((key * ldk0 + ch * 8) * 2));
    else src = (ch * 8 < KW0) ? (k0p + (size_t)(krow + key) * ldk0 + ch * 8) : (k1p + (size_t)(krow + key) * ldk1 + (ch * 8 - KW0));
    kreg[i] = *(const GAS u32x4*)src;
  }
  if (WHICH & 2)
#pragma unroll
  for (int u = 0; u < NVU; ++u) {
    const int id = tid + 256 * u, kp = id / VCH, ch = id % VCH;
    const char* vb = (const char*)(vp + (size_t)krow * ldv);
    vreg[u][0] = *(const GAS u32x4*)(vb + (unsigned)((2 * kp * ldv + ch * 8) * 2));
    vreg[u][1] = *(const GAS u32x4*)(vb + (unsigned)(((2 * kp + 1) * ldv + ch * 8) * 2));
  }
}

template <int DQK, int DV>
DI void attn_sstore(const u32x4 (&kreg)[(64 * (DQK / 8)) / 256], const u32x4 (&vreg)[(32 * (DV / 8)) / 256][2], char* stage, int tid) {
  constexpr int KCH = DQK / 8, NKC = (64 * KCH) / 256, VCH = DV / 8, NVU = (32 * VCH) / 256, KS = DQK + 8, KB = 64 * KS * 2, VSB = DV * 2 + 64;
#pragma unroll
  for (int i = 0; i < NKC; ++i) {
    const int id = tid + 256 * i, key = id / KCH, ch = id % KCH;
    *(u32x4*)(stage + key * (KS * 2) + ch * 16) = kreg[i];
  }
#pragma unroll
  for (int u = 0; u < NVU; ++u) {
    const int id = tid + 256 * u, kp = id / VCH, ch = id % VCH;
    *(u32x4*)(stage + KB + (2 * kp) * VSB + ch * 16) = vreg[u][0];
    *(u32x4*)(stage + KB + (2 * kp + 1) * VSB + ch * 16) = vreg[u][1];
  }
}

template <int DQK, int DV, int KW0, int MODE>
DI void attn_pass(char* smem, const bf16x8 (&qf)[DQK / 16],
                  const bf16_t* __restrict__ k0p, int ldk0, const bf16_t* __restrict__ k1p, int ldk1, const bf16_t* __restrict__ vp, int ldv,
                  int b, int qn, int nkt0, float c, f32x16 (&O)[DV / 32], float& m_io, float& l_io, int tid) {
  constexpr int KS = DQK + 8, KB = 64 * KS * 2, VSB = DV * 2 + 64, VB = 64 * VSB, STG = KB + VB;
  constexpr int NKC = (64 * (DQK / 8)) / 256, NVU = (32 * (DV / 8)) / 256;
  static_assert(2 * STG <= SMEM_BYTES, "attn lds");
  const int lane = tid & 63, wid = tid >> 6, r = lane & 31, h = lane >> 5;
  int nkt, wlo = 0;
  if (MODE == 0) nkt = nkt0; else { wlo = (qn == 0) ? 2 : 0; const int whi = (qn == 15) ? 3 : 5; nkt = 4 + whi - wlo + 1; }
  u32x4 kreg[NKC]; u32x4 vreg[NVU][2];
  float m = m_io, l = l_io;
  constexpr bool QLDS = (DV > 64);
  static_assert(!QLDS || (2 * STG + 4 * (DQK / 16) * 1024 <= SMEM_BYTES), "attn q lds");
  char* qbase = smem + 2 * STG + (wid * (DQK / 16)) * 1024 + lane * 16;
  __syncthreads();
  if (QLDS) {
#pragma unroll
    for (int kk = 0; kk < DQK / 16; ++kk) *(bf16x8*)(qbase + kk * 1024) = qf[kk];
  }
  attn_gload<DQK, DV, KW0, 3>(kreg, vreg, k0p, ldk0, k1p, ldk1, vp, ldv, key_tile_row<MODE>(0, b, qn, wlo), tid);
  attn_sstore<DQK, DV>(kreg, vreg, smem, tid);
  __syncthreads();
  for (int it = 0; it < nkt; ++it) {
    const char* cur = smem + (it & 1) * STG;
    const bool more = (it + 1 < nkt);
    if (DV <= 64) { if (more) attn_gload<DQK, DV, KW0, 3>(kreg, vreg, k0p, ldk0, k1p, ldk1, vp, ldv, key_tile_row<MODE>(it + 1, b, qn, wlo), tid); __builtin_amdgcn_sched_barrier(0); }
    f32x16 S0, S1;
#pragma unroll
    for (int e = 0; e < 16; ++e) { S0[e] = 0.f; S1[e] = 0.f; }
    {
      bf16x8 kfa[DQK / 16], kfb[DQK / 16], qv[DQK / 16];
#pragma unroll
      for (int kk = 0; kk < DQK / 16; ++kk) {
        kfa[kk] = *(const bf16x8*)(cur + r * (KS * 2) + kk * 32 + h * 16);
        kfb[kk] = *(const bf16x8*)(cur + (32 + r) * (KS * 2) + kk * 32 + h * 16);
        qv[kk] = QLDS ? *(const bf16x8*)(qbase + kk * 1024) : qf[kk];
      }
#pragma unroll
      for (int kk = 0; kk < DQK / 16; ++kk) {
        S0 = mfma32(kfa[kk], qv[kk], S0);
        S1 = mfma32(kfb[kk], qv[kk], S1);
      }
      __builtin_amdgcn_sched_group_barrier(0x100, (QLDS ? 3 : 2) * (DQK / 16), 0);
      __builtin_amdgcn_sched_group_barrier(0x008, 2 * (DQK / 16), 0);
    }
    if (MODE == 2) {
      if (it >= 4) {
        const int w = wlo + it - 4;
        if (w < 2 || w > 3) {
          const int kpos0 = (qn - 1) * 128 + 64 * w, qpos = qn * 128 + wid * 32 + r;
#pragma unroll
          for (int e = 0; e < 16; ++e) {
            const int d0 = qpos - (kpos0 + crow(e, h)), d1 = d0 - 32;
            if (d0 > 128 || d0 < -128) S0[e] = -1e30f;
            if (d1 > 128 || d1 < -128) S1[e] = -1e30f;
          }
        }
      }
    }
    float mx = S0[0];
#pragma unroll
    for (int e = 1; e < 16; ++e) mx = fmaxf(mx, S0[e]);
#pragma unroll
    for (int e = 0; e < 16; ++e) mx = fmaxf(mx, S1[e]);
    mx = fmaxf(mx, __shfl_xor(mx, 32));
    const float mn = fmaxf(m, mx);
    const bool grow = __builtin_amdgcn_ballot_w64(mx > m) != 0ull;
    const float alpha = __builtin_amdgcn_exp2f((m - mn) * c);
    m = mn;
    const float mc = mn * c;
    float ps = 0.f;
#pragma unroll
    for (int e = 0; e < 16; ++e) { S0[e] = __builtin_amdgcn_exp2f(S0[e] * c - mc); ps += S0[e]; }
#pragma unroll
    for (int e = 0; e < 16; ++e) { S1[e] = __builtin_amdgcn_exp2f(S1[e] * c - mc); ps += S1[e]; }
    if (grow) {
      l *= alpha;
#pragma unroll
      for (int t = 0; t < DV / 32; ++t)
#pragma unroll
        for (int e = 0; e < 16; ++e) O[t][e] *= alpha;
    }
    l += ps;
    bf16x8 pf[2][2];
#pragma unroll
    for (int s = 0; s < 2; ++s) {
      u32x4 w0, w1;
      w0.x = pk2(S0[8 * s + 0], S0[8 * s + 1]); w0.y = pk2(S0[8 * s + 2], S0[8 * s + 3]); w0.z = pk2(S0[8 * s + 4], S0[8 * s + 5]); w0.w = pk2(S0[8 * s + 6], S0[8 * s + 7]);
      w1.x = pk2(S1[8 * s + 0], S1[8 * s + 1]); w1.y = pk2(S1[8 * s + 2], S1[8 * s + 3]); w1.z = pk2(S1[8 * s + 4], S1[8 * s + 5]); w1.w = pk2(S1[8 * s + 6], S1[8 * s + 7]);
      pf[0][s] = __builtin_bit_cast(bf16x8, w0); pf[1][s] = __builtin_bit_cast(bf16x8, w1);
    }
    {
      const unsigned vaddr = (unsigned)(size_t)(cur + KB) + (unsigned)((4 * h + ((lane & 15) >> 2)) * VSB + ((lane >> 4) & 1) * 32 + (lane & 3) * 8);
      if (DV == 64) {
        s16x4 R[8];
#define PV_TILE64_(T) do { TRV8_192_T##T(R, vaddr); \
          _Pragma("unroll") for (int st = 0; st < 2; ++st) _Pragma("unroll") for (int s = 0; s < 2; ++s) { const int ix = (st * 2 + s) * 2; \
            const bf16x8 va = __builtin_shufflevector(R[ix], R[ix + 1], 0, 1, 2, 3, 4, 5, 6, 7); O[T] = mfma32(va, pf[st][s], O[T]); } } while (0)
        PV_TILE64_(0); PV_TILE64_(1);
#undef PV_TILE64_
      } else {
        s16x4 R[8];
#define PV_TILE_(T) do { TRV8_320_T##T(R, vaddr); \
          _Pragma("unroll") for (int st = 0; st < 2; ++st) _Pragma("unroll") for (int s = 0; s < 2; ++s) { const int ix = (st * 2 + s) * 2; \
            const bf16x8 va = __builtin_shufflevector(R[ix], R[ix + 1], 0, 1, 2, 3, 4, 5, 6, 7); O[(DV > 64) ? T : 0] = mfma32(va, pf[st][s], O[(DV > 64) ? T : 0]); } } while (0)
        PV_TILE_(0); PV_TILE_(1); PV_TILE_(2); PV_TILE_(3);
#undef PV_TILE_
      }
    }
    if (DV > 64) { __builtin_amdgcn_sched_barrier(0); if (more) attn_gload<DQK, DV, KW0, 3>(kreg, vreg, k0p, ldk0, k1p, ldk1, vp, ldv, key_tile_row<MODE>(it + 1, b, qn, wlo), tid); }
    if (more) attn_sstore<DQK, DV>(kreg, vreg, smem + ((it + 1) & 1) * STG, tid);
    __syncthreads();
  }
  m_io = m; l_io = l;
}

template <int DQK, int ROFF, int RDIM>
DI void load_q(bf16x8 (&qf)[DQK / 16], const bf16_t* __restrict__ qrowp, int h, bool rope, const f32x2* __restrict__ cs  ) {
#pragma unroll
  for (int kk = 0; kk < DQK / 16; ++kk) qf[kk] = *(const GAS bf16x8*)(qrowp + kk * 16 + h * 8);
  if (rope) {
    constexpr int NP = RDIM / 32;
#pragma unroll
    for (int p = 0; p < NP; ++p) {
      const int ka = ROFF / 16 + p, kb = ka + NP;
      bf16x8 xa = qf[ka], xb = qf[kb];
      u32x4 oa, ob;
#pragma unroll
      for (int j2 = 0; j2 < 4; ++j2) {
        float o1[2], o2[2];
#pragma unroll
        for (int q = 0; q < 2; ++q) {
          const int j = 2 * j2 + q;
          const f32x2 csv = cs[16 * p + 8 * h + j];
          const float x1 = bf2f((unsigned short)xa[j]), x2 = bf2f((unsigned short)xb[j]);
          o1[q] = x1 * csv.x - x2 * csv.y; o2[q] = x1 * csv.y + x2 * csv.x;
        }
        oa[j2] = pk2(o1[0], o1[1]); ob[j2] = pk2(o2[0], o2[1]);
      }
      qf[ka] = __builtin_bit_cast(bf16x8, oa); qf[kb] = __builtin_bit_cast(bf16x8, ob);
    }
  }
}

template <int NTL> DI void attn_store(const f32x16 (&O)[NTL], float inv, bf16_t* __restrict__ outp, int h) {
#pragma unroll
  for (int t = 0; t < NTL; ++t)
#pragma unroll
    for (int g = 0; g < 4; ++g) {
      u32x2 w; w.x = pk2(O[t][4 * g] * inv, O[t][4 * g + 1] * inv); w.y = pk2(O[t][4 * g + 2] * inv, O[t][4 * g + 3] * inv);
      *(GAS u32x2*)(outp + 32 * t + 8 * g + 4 * h) = w;
    }
}

struct RowIO4 { const float* xin; const bf16_t* y; const float* gate; float* xout; const float* shift; const float* scale; bf16_t* hout; };
DI void rw_rows4(const RowIO4& R, const float* __restrict__ ga, const float* __restrict__ gb, int lane) {
  f32x4 x[4][4]; u32x2 yr[4][4];
  f32x4 ga4[4], gt4[4], gb4[4], sh4[4], sc4[4];
#pragma unroll
  for (int r = 0; r < 4; ++r)
#pragma unroll
    for (int i = 0; i < 4; ++i) x[r][i] = __builtin_nontemporal_load((const GAS f32x4*)(R.xin + r * 1024 + 4 * lane + 256 * i));
  if (R.y) {
#pragma unroll
    for (int r = 0; r < 4; ++r)
#pragma unroll
      for (int i = 0; i < 4; ++i) yr[r][i] = *(const GAS u32x2*)(R.y + r * 1024 + 4 * lane + 256 * i);
#pragma unroll
    for (int i = 0; i < 4; ++i) { ga4[i] = *(const GAS f32x4*)(ga + 4 * lane + 256 * i); gt4[i] = *(const GAS f32x4*)(R.gate + 4 * lane + 256 * i); }
  }
  if (R.hout) {
#pragma unroll
    for (int i = 0; i < 4; ++i) { gb4[i] = *(const GAS f32x4*)(gb + 4 * lane + 256 * i); sh4[i] = *(const GAS f32x4*)(R.shift + 4 * lane + 256 * i); sc4[i] = *(const GAS f32x4*)(R.scale + 4 * lane + 256 * i); }
  }
#pragma unroll
  for (int r = 0; r < 4; ++r) {
    if (R.y) {
      f32x4 yv[4]; float ss = 0.f;
#pragma unroll
      for (int i = 0; i < 4; ++i) {
        yv[i] = (f32x4){bflo(yr[r][i].x), bfhi(yr[r][i].x), bflo(yr[r][i].y), bfhi(yr[r][i].y)};
        ss += yv[i][0] * yv[i][0] + yv[i][1] * yv[i][1] + yv[i][2] * yv[i][2] + yv[i][3] * yv[i][3];
      }
      const float rinv = rsqrtf(wave_sum(ss) * (1.f / 1024.f) + 1e-6f);
#pragma unroll
      for (int i = 0; i < 4; ++i) x[r][i] = x[r][i] + gt4[i] * (yv[i] * rinv * ga4[i]);
    }
    if (R.xout) {
#pragma unroll
      for (int i = 0; i < 4; ++i) __builtin_nontemporal_store(x[r][i], (GAS f32x4*)(R.xout + r * 1024 + 4 * lane + 256 * i));
    }
    if (R.hout) {
      float ss = 0.f;
#pragma unroll
      for (int i = 0; i < 4; ++i) ss += x[r][i][0] * x[r][i][0] + x[r][i][1] * x[r][i][1] + x[r][i][2] * x[r][i][2] + x[r][i][3] * x[r][i][3];
      const float rinv = rsqrtf(wave_sum(ss) * (1.f / 1024.f) + 1e-6f);
#pragma unroll
      for (int i = 0; i < 4; ++i) {
        const f32x4 hv = (x[r][i] * rinv * gb4[i]) * (sc4[i] + 1.f) + sh4[i];
        u32x2 w; w.x = pk2(hv[0], hv[1]); w.y = pk2(hv[2], hv[3]);
        *(GAS u32x2*)(R.hout + r * 1024 + 4 * lane + 256 * i) = w;
      }
    }
  }
}

DI void hyena_item(char* smem, const bf16_t* __restrict__ zin, const bf16_t* __restrict__ xg, const bf16_t* __restrict__ arr, float bias, bf16_t* __restrict__ zout, int tq, int tid) {
  constexpr int CSB = 5184;
  constexpr int ZOFF = 4 * CSB;
  constexpr int ZSB = 528;
  constexpr int ZPB = 32 * ZSB;
  static_assert(ZOFF + 2 * ZPB <= SMEM_BYTES, "hyena lds");
  const int lane = tid & 63, wid = tid >> 6, r = lane & 31, h = lane >> 5;
  const int lo = 1536 - 512 * tq;
  __syncthreads();
  for (int mth = tid; mth < 322; mth += 256) {
    const u32x4 v0 = *(const GAS u32x4*)(arr + lo + 8 * mth), v1 = *(const GAS u32x4*)(arr + lo + 8 * mth + 8);
    const unsigned D0 = v0.x, D1 = v0.y, D2 = v0.z, D3 = v0.w, D4 = v1.x, D5 = v1.y;
    u32x4 c0 = v0;
    u32x4 c1; c1.x = __builtin_amdgcn_alignbyte(D1, D0, 2); c1.y = __builtin_amdgcn_alignbyte(D2, D1, 2); c1.z = __builtin_amdgcn_alignbyte(D3, D2, 2); c1.w = __builtin_amdgcn_alignbyte(D4, D3, 2);
    u32x4 c2; c2.x = D1; c2.y = D2; c2.z = D3; c2.w = D4;
    u32x4 c3; c3.x = __builtin_amdgcn_alignbyte(D2, D1, 2); c3.y = __builtin_amdgcn_alignbyte(D3, D2, 2); c3.z = __builtin_amdgcn_alignbyte(D4, D3, 2); c3.w = __builtin_amdgcn_alignbyte(D5, D4, 2);
    *(u32x4*)(smem + 0 * CSB + 16 * mth) = c0;
    *(u32x4*)(smem + 1 * CSB + 16 * mth) = c1;
    *(u32x4*)(smem + 2 * CSB + 16 * mth) = c2;
    *(u32x4*)(smem + 3 * CSB + 16 * mth) = c3;
  }
  u32x4 zr[4];
  const int zb = tid >> 5, zc = tid & 31;
#pragma unroll
  for (int i = 0; i < 4; ++i) zr[i] = *(const GAS u32x4*)(zin + (size_t)(zb + 8 * i) * 2048 + zc * 8);
#pragma unroll
  for (int i = 0; i < 4; ++i) *(u32x4*)(smem + ZOFF + (zb + 8 * i) * ZSB + zc * 16) = zr[i];
  __syncthreads();
  f32x16 acc[4];
#pragma unroll
  for (int i = 0; i < 4; ++i)
#pragma unroll
    for (int e = 0; e < 16; ++e) acc[i][e] = 0.f;
  const int q = (3 - r) & 3;
  const char* gbase = smem + q * CSB + (511 - 128 * wid - r + 8 * h - q) * 2;
  for (int pnl = 0; pnl < 8; ++pnl) {
    const char* zs = smem + ZOFF + (pnl & 1) * ZPB;
    const bool more = (pnl + 1 < 8);
    if (more) {
#pragma unroll
      for (int i = 0; i < 4; ++i) zr[i] = *(const GAS u32x4*)(zin + (size_t)(zb + 8 * i) * 2048 + (pnl + 1) * 256 + zc * 8);
    }
    __builtin_amdgcn_sched_barrier(0);
#pragma unroll 4
    for (int sc = 0; sc < 16; ++sc) {
      const bf16x8 zf = *(const bf16x8*)(zs + r * ZSB + sc * 32 + h * 16);
      const char* gp = gbase + (pnl * 256 + sc * 16) * 2;
#pragma unroll
      for (int i = 0; i < 4; ++i) {
        const s16x4 g0 = *(const s16x4*)(gp - 64 * i), g1 = *(const s16x4*)(gp - 64 * i + 8);
        const bf16x8 gf = __builtin_shufflevector(g0, g1, 0, 1, 2, 3, 4, 5, 6, 7);
        acc[i] = mfma32(gf, zf, acc[i]);
      }
    }
    if (more) {
      char* zn = smem + ZOFF + ((pnl + 1) & 1) * ZPB;
#pragma unroll
      for (int i = 0; i < 4; ++i) *(u32x4*)(zn + (zb + 8 * i) * ZSB + zc * 16) = zr[i];
    }
    __syncthreads();
  }
#pragma unroll
  for (int i = 0; i < 4; ++i) {
    const int t0 = 512 * tq + 128 * wid + 32 * i;
#pragma unroll
    for (int g = 0; g < 4; ++g) {
      const size_t off = (size_t)r * 2048 + t0 + 8 * g + 4 * h;
      const u32x2 zw = *(const GAS u32x2*)(zin + off), xw = *(const GAS u32x2*)(xg + off);
      const float o0 = bflo(xw.x) * (acc[i][4 * g + 0] + bias * bflo(zw.x));
      const float o1 = bfhi(xw.x) * (acc[i][4 * g + 1] + bias * bfhi(zw.x));
      const float o2 = bflo(xw.y) * (acc[i][4 * g + 2] + bias * bflo(zw.y));
      const float o3 = bfhi(xw.y) * (acc[i][4 * g + 3] + bias * bfhi(zw.y));
      u32x2 w; w.x = pk2(o0, o1); w.y = pk2(o2, o3);
      *(GAS u32x2*)(zout + off) = w;
    }
  }
}

DI int wt_map(int mode, int d) {
  if (mode == 0) return d;
  if (mode == 1) { if (d < 640) return d; if (d < 2176) return d + 32; if (d < 2208) return d - 2176 + 640; return -1; }
  const int tile = d >> 7, w = d & 127;
  return (w < 64) ? (tile * 64 + w) : (2816 + tile * 64 + (w - 64));
}
DI void wt_item(const float* __restrict__ W, int ldw, int K, bf16_t* __restrict__ Wt, int k0, int d0, int mode, char* smem, int tid) {
  float* tile = (float*)smem;
  __syncthreads();
  {
    const int j = tid & 63, kq = tid >> 6;
    const int src = wt_map(mode, d0 + j);
#pragma unroll
    for (int i = 0; i < 16; ++i) {
      const int k = kq + 4 * i;
      tile[k * 65 + j] = (src >= 0) ? *(const GAS float*)(W + (size_t)(k0 + k) * ldw + src) : 0.f;
    }
  }
  __syncthreads();
#pragma unroll
  for (int u = 0; u < 2; ++u) {
    const int id = tid + 256 * u, j = id >> 3, k8 = (id & 7) * 8;
    float v[8];
#pragma unroll
    for (int e = 0; e < 8; ++e) v[e] = tile[(k8 + e) * 65 + j];
    u32x4 w; w.x = pk2(v[0], v[1]); w.y = pk2(v[2], v[3]); w.z = pk2(v[4], v[5]); w.w = pk2(v[6], v[7]);
    *(GAS u32x4*)(Wt + (size_t)(d0 + j) * K + k0 + k8) = w;
  }
}

DI void ada_item(const float* __restrict__ c, const float* __restrict__ cctx, const float* __restrict__ adaw, const float* __restrict__ adab, float* __restrict__ MODp, int item, char* smem, int tid) {
  const int layer = item / 192, rem = item % 192, nb = rem / 8, kc = rem % 8;
  float* s = (float*)smem;
  __syncthreads();
  for (int idx = tid; idx < 36 * 128; idx += 256) {
    const int k = idx / 36, rr = idx % 36;
    float v = 0.f;
    if (rr < 32) v = siluf(c[rr * 1024 + kc * 128 + k]); else if (rr == 32) v = siluf(cctx[kc * 128 + k]);
    s[idx] = v;
  }
  __syncthreads();
  const int n = nb * 256 + tid;
  const float* W = adaw + (size_t)layer * 1024 * 6144 + (size_t)(kc * 128) * 6144 + n;
  float acc[36];
  const float b0 = (kc == 0) ? adab[layer * 6144 + n] : 0.f;
#pragma unroll
  for (int rr = 0; rr < 36; ++rr) acc[rr] = b0;
#pragma unroll 2
  for (int k = 0; k < 128; ++k) {
    const float w = *(const GAS float*)(W + (size_t)k * 6144);
#pragma unroll
    for (int r4 = 0; r4 < 9; ++r4) {
      const f32x4 sv = *(const f32x4*)(s + k * 36 + 4 * r4);
      acc[4 * r4 + 0] += sv[0] * w; acc[4 * r4 + 1] += sv[1] * w; acc[4 * r4 + 2] += sv[2] * w; acc[4 * r4 + 3] += sv[3] * w;
    }
  }
  float* MOD = MODp + (size_t)layer * 33 * 6144 + n;
#pragma unroll
  for (int rr = 0; rr < 33; ++rr) unsafeAtomicAdd(MOD + (size_t)rr * 6144, acc[rr]);
}

DI void filt_item(const KParams* p, int item, char* smem, int tid) {
  float* feats = (float*)smem;
  float* h1 = feats + 8 * 33;
  float* h2 = h1 + 8 * 64;
  const float* w1 = p->in[23]; const float* b1 = p->in[24]; const float* w2 = p->in[25]; const float* b2 = p->in[26];
  const float* w3 = p->in[27]; const float* b3 = p->in[28]; const float* fq = p->in[29];
  const int t0 = item * 8;
  __syncthreads();
  for (int idx = tid; idx < 8 * 33; idx += 256) {
    const int tl = idx / 33, f = idx % 33; const float t = (float)(t0 + tl);
    float v;
    if (f == 0) v = t / 2047.f;
    else {
      const int band = (f - 1) & 15;
      const float bv = 1e-4f + (float)band * ((15.f - 1e-4f) / 15.f);
      const float ang = (6.283185307179586f * bv) * t / 2048.f;
      v = (f <= 16) ? cosf(ang) : -sinf(ang);
    }
    feats[idx] = v;
  }
  __syncthreads();
  for (int idx = tid; idx < 512; idx += 256) {
    const int tl = idx >> 6, j = idx & 63;
    float a = b1[j];
#pragma unroll 3
    for (int f = 0; f < 33; ++f) a += feats[tl * 33 + f] * w1[f * 64 + j];
    h1[idx] = sinf(fq[j] * a);
  }
  __syncthreads();
  for (int idx = tid; idx < 512; idx += 256) {
    const int tl = idx >> 6, j = idx & 63;
    float a = b2[j];
#pragma unroll 4
    for (int f = 0; f < 64; ++f) a += h1[tl * 64 + f] * w2[f * 64 + j];
    h2[idx] = sinf(fq[j] * a);
  }
  __syncthreads();
  bf16_t* GARR = (bf16_t*)(p->ws + OFF_GARR);
  const float min_decay = -3.0701134573253945f, max_decay = -15.350567286626973f;
#pragma unroll 1
  for (int ci = 0; ci < 8; ++ci) {
    const int col = tid + 256 * ci;
    float acc[8];
    const float bb = b3[col];
#pragma unroll
    for (int tl = 0; tl < 8; ++tl) acc[tl] = bb;
#pragma unroll 4
    for (int j = 0; j < 64; ++j) {
      const float w = w3[j * 2048 + col];
#pragma unroll
      for (int tl = 0; tl < 8; ++tl) acc[tl] += h2[tl * 64 + j] * w;
    }
    const int dir = col >> 10, n = (col >> 9) & 1, ch = col & 511;
    const float delta = fabsf(min_decay + (max_decay - min_decay) * ((float)ch / 511.f));
    bf16_t* dst = GARR + ((size_t)(n * 512 + ch)) * 4096;
#pragma unroll
    for (int tl = 0; tl < 8; ++tl) {
      const int t = t0 + tl;
      const float val = acc[tl] * expf(-((float)t / 2047.f) * delta);
      if (dir == 0) dst[2047 - t] = f2bf(val);
      else { if (t >= 1) dst[2047 + t] = f2bf(val); if (t == 2047) dst[4095] = 0; }
    }
  }
}

DI int xcd_item(int j, int xcd, int NX, int GS) { const int gl = j / GS, w = j - gl * GS; return (gl * NX + xcd) * GS + w; }
DI void gemm_tile_of(int j, int xcd, int NX, int NTn, int GN, int& mt, int& nt) {
  const int gs = 8 * GN, stl = j / gs, w = j - stl * gs, st = stl * NX + xcd, nsn = NTn / GN, sm = st / nsn, sn = st - sm * nsn;
  mt = sm * 8 + (w & 7); nt = sn * GN + (w >> 3);
}

#define XB_TMO      128
#define XB_XCNT(j)  (256  + 64 * (j))
#define XB_XSUB(j)  (1280 + 64 * (j))
#define XB_XGEN(j)  (2304 + 64 * (j))
#define XB_TOP      3328
#define XB_TOPGEN   3392
#define XB_SPIN_CAP (1u << 22)
DI unsigned xb_ld(unsigned* p)              { return __hip_atomic_load(p, __ATOMIC_RELAXED, __HIP_MEMORY_SCOPE_AGENT); }
DI unsigned xb_add(unsigned* p, unsigned v) { return __hip_atomic_fetch_add(p, v, __ATOMIC_RELAXED, __HIP_MEMORY_SCOPE_AGENT); }
DI unsigned xb_xcc_id() { return (unsigned)__builtin_amdgcn_s_getreg((3 << 11) | 20) & 0xFu; }
#define XB_SPIN(cond, bar) do { unsigned _sp = 0; while (cond) { __builtin_amdgcn_s_sleep(1); \
    if ((++_sp & 255u) == 0u) { if (xb_ld(&(bar)[XB_TMO])) break; if (_sp > XB_SPIN_CAP) { atomicAdd(&(bar)[XB_TMO], 1u); break; } } } } while (0)
DI void xcd_barrier_complete(unsigned* bar, unsigned x, unsigned& nloc, unsigned& nx) {
  const unsigned Gn = gridDim.x;
  unsigned sum, cnt, mine, sp = 0u;
  for (;;) {
    sum = 0u; cnt = 0u; mine = 0u;
#pragma unroll
    for (unsigned j = 0; j < 16; ++j) { const unsigned c = xb_ld(&bar[XB_XCNT(j)]); sum += c; cnt += (c > 0u) ? 1u : 0u; mine = (j == x) ? c : mine; }
    if (sum == Gn) break;
    __builtin_amdgcn_s_sleep(1);
    if ((++sp & 255u) == 0u) { if (xb_ld(&bar[XB_TMO])) break; if (sp > XB_SPIN_CAP) { atomicAdd(&bar[XB_TMO], 1u); break; } }
  }
  nloc = mine > 0u ? mine : 1u; nx = cnt > 0u ? cnt : 1u;
}
DI void xcd_barrier(unsigned* bar, unsigned x, volatile LAS unsigned* st) {
  asm volatile("s_waitcnt vmcnt(0)" ::: "memory");
  __syncthreads();
  if (threadIdx.x == 0) {
    __builtin_amdgcn_s_waitcnt(0);
    unsigned nloc = st[0], nx = st[1];
    if (nloc == 0u) { xcd_barrier_complete(bar, x, nloc, nx); st[0] = nloc; st[1] = nx; }
    const unsigned old = xb_add(&bar[XB_XSUB(x)], 1u);
    const unsigned gen = old / nloc;
    if (old + 1u == (gen + 1u) * nloc) {
      __builtin_amdgcn_fence(__ATOMIC_RELEASE, "agent");
      asm volatile("s_waitcnt vmcnt(0)" ::: "memory");
      const unsigned og = xb_add(&bar[XB_TOP], 1u);
      const unsigned tg = og / nx;
      if (og + 1u == (tg + 1u) * nx) xb_add(&bar[XB_TOPGEN], 1u);
      else XB_SPIN(xb_ld(&bar[XB_TOPGEN]) == tg, bar);
      __builtin_amdgcn_fence(__ATOMIC_ACQUIRE, "agent");
      xb_add(&bar[XB_XGEN(x)], 1u);
      asm volatile("s_waitcnt vmcnt(0)" ::: "memory");
    } else {
      XB_SPIN(xb_ld(&bar[XB_XGEN(x)]) == gen, bar);
      __builtin_amdgcn_fence(__ATOMIC_ACQUIRE, "agent");
      asm volatile("s_waitcnt vmcnt(0)" ::: "memory");
    }
  }
  __syncthreads();
}

__global__ void __launch_bounds__(256, 2) fwd_kernel(Params p) {
  extern __shared__ __attribute__((aligned(16))) char smem[];
  cg::grid_group grid = cg::this_grid();
  const int G = gridDim.x, bid = blockIdx.x, NW = G * 4;
  __shared__ uint4 xb_words;
  if (threadIdx.x == 0) xb_words = make_uint4(0u, 0u, 0u, 0u);
  __syncthreads();
  unsigned* const xbar = (unsigned*)(p.ws + OFF_BAR);
  const unsigned xb_x = xb_xcc_id();
  if (threadIdx.x == 0) (void)xb_add(&xbar[XB_XCNT(xb_x)], 1u);
  const int NX = ((G & 7) == 0) ? 8 : 1, xcd = bid % NX, slot = bid / NX, nslot = G / NX;
#define WT_IN0 ((const bf16_t*)(ws + OFF_WT_IN0))
#define WT_UQ ((const bf16_t*)(ws + OFF_WT_UQ))
#define WT_UKV ((const bf16_t*)(ws + OFF_WT_UKV))
#define WT_IN1 ((const bf16_t*)(ws + OFF_WT_IN1))
#define MOD ((float*)(ws + OFF_MOD))
#define CS64 ((const f32x2*)(ws + OFF_CS64))
#define CS32 ((const f32x2*)(ws + OFF_CS32))
#define XC ((float*)(ws + OFF_XC))
#define XL (pp->out)
#define H ((bf16_t*)(ws + OFF_H))
#define P ((bf16_t*)(ws + OFF_P))
#define Q ((bf16_t*)(ws + OFF_Q))
#define KV ((bf16_t*)(ws + OFF_KV))
#define MI ((bf16_t*)(ws + OFF_MI))
#define Y ((bf16_t*)(ws + OFF_Y))
#define GB ((bf16_t*)(ws + OFF_G))
#define BND ((float*)(ws + OFF_BND))
#define HT ((bf16_t*)(ws + OFF_HT))
#define Z1T ((bf16_t*)(ws + OFF_Z1T))
#define Z2T ((bf16_t*)(ws + OFF_Z2T))
#define norm_g (pp->in[6])

#ifdef PROBE_MASK
  bool rep_done = false;
#endif
  for (int ph = p.ph_lo; ph < p.ph_hi; ++ph) {
    int tid = threadIdx.x; asm volatile("" : "+v"(tid));
    const KParams* pp = (const KParams*)__builtin_amdgcn_kernarg_segment_ptr(); asm volatile("" : "+s"(pp));
    char* ws = pp->ws; asm volatile("" : "+s"(ws));
    const int lane = tid & 63, wid = __builtin_amdgcn_readfirstlane(tid >> 6);
    const int gw = bid * 4 + wid;
    if (ph == 0) {
      for (int item = bid; item < 1024 + 6024; item += G) {
        if (item < 256) filt_item(pp, item, smem, tid);
        else if (item < 640) ada_item(pp->in[1], pp->in[3], pp->in[4], pp->in[5], (float*)(ws + OFF_MOD), item - 256, smem, tid);
        else if (item < 1024) {
          const int idx = (item - 640) * 256 + tid;
          const int t = idx / 48, e = idx % 48;
          const float row = (float)(t >> 6), col = (float)(t & 63);
          if (e < 32) { const int i = e; const float inv = exp2f(-(float)(i & 15) * (13.287712379549449f / 16.f)); const float ang = ((i < 16) ? row : col) * inv;
            ((f32x2*)(ws + OFF_CS64))[t * 32 + i] = (f32x2){cosf(ang), sinf(ang)}; }
          else { const int i = e - 32; const float inv = exp2f(-(float)(i & 7) * (13.287712379549449f / 8.f)); const float ang = ((i < 8) ? row : col) * inv;
            ((f32x2*)(ws + OFF_CS32))[t * 16 + i] = (f32x2){cosf(ang), sinf(ang)}; }
        } else {
          int r = item - 1024;
          const float* W; int ldw, K, nd, mode = 0; size_t off;
          if (r < 576) { W = pp->in[12]; ldw = 2208; K = 1024; nd = 36; mode = 1; off = OFF_WT_IN0; }
          else if ((r -= 576) < 72) { W = pp->in[14]; ldw = 768; K = 384; nd = 12; off = OFF_WT_UQ; }
          else if ((r -= 72) < 64) { W = pp->in[16]; ldw = 1024; K = 256; nd = 16; off = OFF_WT_UKV; }
          else if ((r -= 64) < 256) { W = pp->in[7]; ldw = 1024; K = 1024; nd = 16; off = OFF_WT_OUT0; }
          else if ((r -= 256) < 256) { W = pp->in[7] + 1048576; ldw = 1024; K = 1024; nd = 16; off = OFF_WT_OUT1; }
          else if ((r -= 256) < 1408) { W = pp->in[8]; ldw = 5632; K = 1024; nd = 88; mode = 2; off = OFF_WT_UP0; }
          else if ((r -= 1408) < 1408) { W = pp->in[8] + (size_t)1024 * 5632; ldw = 5632; K = 1024; nd = 88; mode = 2; off = OFF_WT_UP1; }
          else if ((r -= 1408) < 704) { W = pp->in[11]; ldw = 1024; K = 2816; nd = 16; off = OFF_WT_DN0; }
          else if ((r -= 704) < 704) { W = pp->in[11] + (size_t)2816 * 1024; ldw = 1024; K = 2816; nd = 16; off = OFF_WT_DN1; }
          else { r -= 704; W = pp->in[19]; ldw = 2304; K = 1024; nd = 36; off = OFF_WT_IN1; }
          const int kt = r / nd, dt = r % nd;
          wt_item(W, ldw, K, (bf16_t*)(ws + off), kt * 64, dt * 64, mode, smem, tid);
        }
      }
    }
    else if (ph == 1) {
      for (int gi = gw; gi < NT / 4; gi += NW) {
        const int row = gi * 4;
        const int mr = (row < NL) ? (row >> 11) : 32;
        const float* md = MOD + (size_t)mr * 6144;
        RowIO4 io;
        io.xin = (row < NL) ? pp->in[0] + (size_t)row * 1024 : pp->in[2] + (size_t)(row - NL) * 1024;
        io.y = nullptr; io.gate = nullptr; io.xout = nullptr; io.shift = md; io.scale = md + 1024; io.hout = H + (size_t)row * 1024;
        rw_rows4(io, nullptr, norm_g, lane);
      }
    }
    else if (ph == 2) {
      const EpiArgs ea{P, PLD, nullptr, nullptr, nullptr};
      for (int j = slot; j < 576 * 9 / NX; j += nslot) { int mt, nt; gemm_tile_of(j, xcd, NX, 9, 9, mt, nt);
        gemm_tile256<0>(H, 1024, WT_IN0, 1024, mt, nt, smem, tid, ea); }
    }
    else if (ph == 3) {
      const float* gq = pp->in[13]; const float* gkv = pp->in[15];
      for (int row = gw; row < NT; row += NW) {
        unsigned wq[3], wk[2], d0[2], d1[2], kr0 = 0, kr1 = 0;
        f32x4 cd[2], ck = {0.f, 0.f, 0.f, 0.f};
        const bool lat = row < NL;
        const int t = row & 2047;
        bf16_t* pr = P + (size_t)row * PLD;
#pragma unroll
        for (int i = 0; i < 3; ++i) wq[i] = *(const GAS unsigned*)(pr + PE_CQ + 2 * lane + 128 * i);
#pragma unroll
        for (int i = 0; i < 2; ++i) wk[i] = *(const GAS unsigned*)(pr + PE_CKV + 2 * lane + 128 * i);
        if (lat) {
#pragma unroll
          for (int u = 0; u < 2; ++u) {
            const int dp = lane + 64 * u, grp = dp >> 4, i2 = (dp & 15) * 2;
            d0[u] = *(const GAS unsigned*)(pr + PE_DK + grp * 64 + i2);
            d1[u] = *(const GAS unsigned*)(pr + PE_DK + grp * 64 + i2 + 32);
            cd[u] = *(const GAS f32x4*)((const float*)(CS64 + t * 32 + i2));
          }
          if (lane < 8) {
            kr0 = *(const GAS unsigned*)(pr + PE_KR + 2 * lane);
            kr1 = *(const GAS unsigned*)(pr + PE_KR + 2 * lane + 16);
            ck = *(const GAS f32x4*)((const float*)(CS32 + t * 16 + 2 * lane));
          }
        }
        f32x2 g2q[3], g2k[2];
#pragma unroll
        for (int i = 0; i < 3; ++i) g2q[i] = *(const GAS f32x2*)(gq + 2 * lane + 128 * i);
#pragma unroll
        for (int i = 0; i < 2; ++i) g2k[i] = *(const GAS f32x2*)(gkv + 2 * lane + 128 * i);
        float ss = 0.f;
#pragma unroll
        for (int i = 0; i < 3; ++i) { const float a = bflo(wq[i]), bq = bfhi(wq[i]); ss += a * a + bq * bq; }
        const float rq = rsqrtf(wave_sum(ss) * (1.f / 384.f) + 1e-6f);
        float s2 = 0.f;
#pragma unroll
        for (int i = 0; i < 2; ++i) { const float a = bflo(wk[i]), bq = bfhi(wk[i]); s2 += a * a + bq * bq; }
        const float rk = rsqrtf(wave_sum(s2) * (1.f / 256.f) + 1e-6f);
#pragma unroll
        for (int i = 0; i < 3; ++i) *(GAS unsigned*)(pr + PE_CQ + 2 * lane + 128 * i) = pk2(bflo(wq[i]) * rq * g2q[i].x, bfhi(wq[i]) * rq * g2q[i].y);
#pragma unroll
        for (int i = 0; i < 2; ++i) *(GAS unsigned*)(pr + PE_CKV + 2 * lane + 128 * i) = pk2(bflo(wk[i]) * rk * g2k[i].x, bfhi(wk[i]) * rk * g2k[i].y);
        if (lat) {
#pragma unroll
          for (int u = 0; u < 2; ++u) {
            const int dp = lane + 64 * u, grp = dp >> 4, i2 = (dp & 15) * 2;
            const float xa0 = bflo(d0[u]), xa1 = bfhi(d0[u]), xb0 = bflo(d1[u]), xb1 = bfhi(d1[u]);
            const f32x4 c4 = cd[u];
            *(GAS unsigned*)(pr + PE_DK + grp * 64 + i2) = pk2(xa0 * c4[0] - xb0 * c4[1], xa1 * c4[2] - xb1 * c4[3]);
            *(GAS unsigned*)(pr + PE_DK + grp * 64 + i2 + 32) = pk2(xa0 * c4[1] + xb0 * c4[0], xa1 * c4[3] + xb1 * c4[2]);
          }
          if (lane < 8) {
            const float xa0 = bflo(kr0), xa1 = bfhi(kr0), xb0 = bflo(kr1), xb1 = bfhi(kr1);
            *(GAS unsigned*)(pr + PE_KR + 2 * lane) = pk2(xa0 * ck[0] - xb0 * ck[1], xa1 * ck[2] - xb1 * ck[3]);
            *(GAS unsigned*)(pr + PE_KR + 2 * lane + 16) = pk2(xa0 * ck[1] + xb0 * ck[0], xa1 * ck[3] + xb1 * ck[2]);
          }
        }
      }
    }
    else if (ph == 4) {
      const EpiArgs eq{Q, 768, nullptr, nullptr, nullptr}, ekv{KV, 1024, nullptr, nullptr, nullptr};
      for (int j = slot; j < 576 * 7 / NX; j += nslot) {
        int mt, nt;
        if (j < 576 * 3 / NX) { gemm_tile_of(j, xcd, NX, 3, 3, mt, nt); gemm_tile256<0>(P + PE_CQ, PLD, WT_UQ, 384, mt, nt, smem, tid, eq); }
        else { gemm_tile_of(j - 576 * 3 / NX, xcd, NX, 4, 4, mt, nt); gemm_tile256<0>(P + PE_CKV, PLD, WT_UKV, 256, mt, nt, smem, tid, ekv); }
      }
    }
    else if (ph == 5) {   }
    else if (ph == 6) {
      const int r = lane & 31, h = lane >> 5;
      for (int j = slot; j < 4608 / NX; j += nslot) {
        const int item = (j < 4096 / NX) ? xcd_item(j, xcd, NX, 16) : 4096 + (j - 4096 / NX) * NX + xcd;
        const bool is_ctx = (item >= 4096);
        {
          int b, hh, qt, qrow0;
          if (!is_ctx) { const int idx = item; b = idx >> 7; hh = (idx >> 4) & 7; qt = idx & 15; qrow0 = b * 2048 + qt * 128; }
          else { const int idx = item - 4096; b = idx >> 4; hh = (idx >> 1) & 7; qt = idx & 1; qrow0 = NL + b * 256 + qt * 128; }
          const int qr = qrow0 + wid * 32 + r;
          bf16x8 qf[6];
          load_q<96, 64, 32>(qf, Q + (size_t)qr * 768 + hh * 96, h, !is_ctx, CS32 + (size_t)(qr & 2047) * 16);
          f32x16 O[2];
#pragma unroll
          for (int t = 0; t < 2; ++t)
#pragma unroll
            for (int e = 0; e < 16; ++e) O[t][e] = 0.f;
          float m = -1e30f, l = 0.f;
          const float c = 0.10206207261596575f * 1.4426950408889634f;
          attn_pass<96, 64, 64, 0>(smem, qf, KV + hh * 128, 1024, P + PE_KR, PLD, KV + hh * 128 + 64, 1024, b, qt, is_ctx ? 4 : 36, c, O, m, l, tid);
          l += __shfl_xor(l, 32);
          attn_store<2>(O, 1.f / l, MI + (size_t)qr * 1024 + hh * 64, h);
        }
      }
      for (int j = nslot - 1 - slot; j < 2304 / NX; j += nslot) {
        const int item = (j < 2048 / NX) ? xcd_item(j, xcd, NX, 16) : 2048 + (j - 2048 / NX) * NX + xcd;
        const bool is_ctx = (item >= 2048);
        {
          int b, hh, qt, qrow0;
          if (!is_ctx) { const int idx = item; b = idx >> 6; hh = (idx >> 4) & 3; qt = idx & 15; qrow0 = b * 2048 + qt * 128; }
          else { const int idx = item - 2048; b = idx >> 3; hh = (idx >> 1) & 3; qt = idx & 1; qrow0 = NL + b * 256 + qt * 128; }
          const int qr = qrow0 + wid * 32 + r;
          const float c = 0.125f * 1.4426950408889634f;
          bf16_t* outp = MI + (size_t)qr * 1024 + 512 + hh * 128;
          float lam;
          { const float* dl = pp->in[17]; const float a = wave_sum(dl[lane] * dl[64 + lane]), bq = wave_sum(dl[128 + lane] * dl[192 + lane]); lam = __expf(a) - __expf(bq) + 0.2f; }
          float ss = 0.f;
#pragma unroll 1
          for (int sm = 0; sm < 2; ++sm) {
            bf16x8 qf[4];
            load_q<64, 0, 64>(qf, P + (size_t)qr * PLD + PE_DQ + hh * 128 + sm * 64, h, !is_ctx, CS64 + (size_t)(qr & 2047) * 32);
            f32x16 O[4];
#pragma unroll
            for (int t = 0; t < 4; ++t)
#pragma unroll
              for (int e = 0; e < 16; ++e) O[t][e] = 0.f;
            float m = -1e30f, l = 0.f;
            const bf16_t* kp = P + PE_DK + hh * 128 + sm * 64; const bf16_t* vp = P + PE_DV + hh * 128;
            attn_pass<64, 128, 64, 0>(smem, qf, kp, PLD, kp, PLD, vp, PLD, b, qt, is_ctx ? 4 : 36, c, O, m, l, tid);
            l += __shfl_xor(l, 32);
            const float inv = 1.f / l;
            if (sm == 0) {
              attn_store<4>(O, inv, outp, h);
            } else {
#pragma unroll
              for (int t = 0; t < 4; ++t)
#pragma unroll
                for (int g = 0; g < 4; ++g) {
                  const u32x2 w = *(const GAS u32x2*)(outp + 32 * t + 8 * g + 4 * h);
                  const float v0 = bflo(w.x) - lam * O[t][4 * g + 0] * inv, v1 = bfhi(w.x) - lam * O[t][4 * g + 1] * inv;
                  const float v2 = bflo(w.y) - lam * O[t][4 * g + 2] * inv, v3 = bfhi(w.y) - lam * O[t][4 * g + 3] * inv;
                  ss += v0 * v0 + v1 * v1 + v2 * v2 + v3 * v3;
                  O[t][4 * g + 0] = v0; O[t][4 * g + 1] = v1; O[t][4 * g + 2] = v2; O[t][4 * g + 3] = v3;
                }
              attn_store<4>(O, 1.f, outp, h);
            }
          }
          ss += __shfl_xor(ss, 32);
          const float rinv = rsqrtf(ss * (1.f / 128.f) + 1e-6f) * 0.8f;
          const float* subg = pp->in[18];
#pragma unroll
          for (int t = 0; t < 4; ++t)
#pragma unroll
            for (int g = 0; g < 4; ++g) {
              bf16_t* a = outp + 32 * t + 8 * g + 4 * h;
              const u32x2 w = *(const GAS u32x2*)a;
              const f32x4 g4 = *(const GAS f32x4*)(subg + 32 * t + 8 * g + 4 * h);
              u32x2 o; o.x = pk2(bflo(w.x) * rinv * g4[0], bfhi(w.x) * rinv * g4[1]); o.y = pk2(bflo(w.y) * rinv * g4[2], bfhi(w.y) * rinv * g4[3]);
              *(GAS u32x2*)a = o;
            }
        }
      }
    }
    else if (ph == 7 || ph == 18) {
      const int nmt = (ph == 7) ? 576 : 512;
      const bf16_t* Wt = (const bf16_t*)(ws + ((ph == 7) ? OFF_WT_OUT0 : OFF_WT_OUT1));
      const EpiArgs ea{Y, 1024, nullptr, nullptr, nullptr};
      for (int j = slot; j < nmt * 4 / NX; j += nslot) { int mt, nt; gemm_tile_of(j, xcd, NX, 4, 4, mt, nt);
        gemm_tile256<0>(MI, 1024, Wt, 1024, mt, nt, smem, tid, ea); }
    }
    else if (ph == 8 || ph == 12 || ph == 19 || ph == 23) {
      const int layer = (ph >= 19) ? 1 : 0;
      const bool second = (ph == 12 || ph == 23);
      const int nrows = (ph >= 19) ? NL : NT;
      const float* ga = norm_g + (size_t)layer * 4096 + (second ? 3072 : 1024);
      const float* gb = second ? (norm_g + 4096) : (norm_g + (size_t)layer * 4096 + 2048);
      for (int gi = gw; gi < nrows / 4; gi += NW) {
        const int row = gi * 4;
        const bool lat = row < NL;
        const int mr = lat ? (row >> 11) : 32;
        const float* md = MOD + ((size_t)layer * 33 + mr) * 6144;
        RowIO4 io;
        if (lat) { io.xin = (ph == 8) ? pp->in[0] + (size_t)row * 1024 : XL + (size_t)row * 1024; io.xout = XL + (size_t)row * 1024; }
        else { io.xin = (ph == 8) ? pp->in[2] + (size_t)(row - NL) * 1024 : XC + (size_t)(row - NL) * 1024; io.xout = XC + (size_t)(row - NL) * 1024; }
        io.y = Y + (size_t)row * 1024;
        io.gate = md + (second ? 5120 : 2048);
        if (ph == 23) { io.shift = nullptr; io.scale = nullptr; io.hout = nullptr; }
        else if (ph == 12) { const float* md1 = MOD + ((size_t)33 + mr) * 6144; io.shift = md1; io.scale = md1 + 1024; io.hout = H + (size_t)row * 1024; }
        else { io.shift = md + 3072; io.scale = md + 4096; io.hout = H + (size_t)row * 1024; }
        rw_rows4(io, ga, gb, lane);
      }
    }
    else if (ph == 9 || ph == 20) {
      const int layer = (ph == 20) ? 1 : 0, nmt = (ph == 9) ? 576 : 512;
      const bf16_t* Wt = (const bf16_t*)(ws + (layer ? OFF_WT_UP1 : OFF_WT_UP0));
      const float* cw = pp->in[9] + (size_t)layer * 3 * 5632; const float* cb = pp->in[10] + (size_t)layer * 5632;
      const EpiArgs ea{GB, 2816, BND, cw, cb};
#ifdef PROBE_GEMM_VAR
      if (ph == 9) {
        for (int j = slot; j < nmt * 22 / NX; j += nslot) { int mt, nt; gemm_tile_of(j, xcd, NX, 22, 11, mt, nt);
          gemm_tile256<1, PROBE_GEMM_VAR>(H, 1024, Wt, 1024, mt, nt, smem, tid, ea); }
        grid.sync();
      }
#endif
      for (int j = slot; j < nmt * 22 / NX; j += nslot) { int mt, nt; gemm_tile_of(j, xcd, NX, 22, 11, mt, nt);
        gemm_tile256<1>(H, 1024, Wt, 1024, mt, nt, smem, tid, ea); }
    }
    else if (ph == 10 || ph == 21) {
      const int layer = (ph == 21) ? 1 : 0, nmt = (ph == 10) ? 576 : 512;
      const float* cw = pp->in[9] + (size_t)layer * 3 * 5632; const float* cb = pp->in[10] + (size_t)layer * 5632;
      for (int item = bid; item < nmt * 2; item += G) {
        const int mt = item >> 1, side = item & 1, m0 = mt * 128, L = (mt < 512) ? 2048 : 256;
        const float *pv, *cu, *nx; int orow;
        if (side == 0) { if ((m0 % L) == 0) continue; pv = BND + (size_t)((mt - 1) * 4 + 3) * 5632; cu = BND + (size_t)(mt * 4 + 0) * 5632; nx = BND + (size_t)(mt * 4 + 1) * 5632; orow = m0; }
        else { if (((m0 + 128) % L) == 0) continue; pv = BND + (size_t)(mt * 4 + 2) * 5632; cu = BND + (size_t)(mt * 4 + 3) * 5632; nx = BND + (size_t)((mt + 1) * 4 + 0) * 5632; orow = m0 + 127; }
        for (int j = tid; j < 2816; j += 256) {
          const int ca = (j >> 6) * 128 + (j & 63), cgc = ca + 64;
          const float ua = cw[j] * pv[ca] + cw[5632 + j] * cu[ca] + cw[11264 + j] * nx[ca] + cb[j];
          const float ug = cw[2816 + j] * pv[cgc] + cw[5632 + 2816 + j] * cu[cgc] + cw[11264 + 2816 + j] * nx[cgc] + cb[2816 + j];
          GB[(size_t)orow * 2816 + j] = f2bf(siluf(ug) * ua);
        }
      }
    }
    else if (ph == 11 || ph == 22) {
      const int layer = (ph == 22) ? 1 : 0, nmt = (ph == 11) ? 576 : 512;
      const bf16_t* Wt = (const bf16_t*)(ws + (layer ? OFF_WT_DN1 : OFF_WT_DN0));
      const EpiArgs ea{Y, 1024, nullptr, nullptr, nullptr};
      for (int j = slot; j < nmt * 4 / NX; j += nslot) { int mt, nt; gemm_tile_of(j, xcd, NX, 4, 4, mt, nt);
        gemm_tile256<0>(GB, 2816, Wt, 2816, mt, nt, smem, tid, ea); }
    }
    else if (ph == 13) {
      const EpiArgs ea{P, PLD, nullptr, nullptr, nullptr};
      for (int j = slot; j < (512 * 9 + 64) / NX; j += nslot) {
        int mt, nt;
        if (j < 512 * 9 / NX) gemm_tile_of(j, xcd, NX, 9, 9, mt, nt); else { mt = 512 + (j - 512 * 9 / NX) * NX + xcd; nt = 2; }
        gemm_tile256<0>(H, 1024, WT_IN1, 1024, mt, nt, smem, tid, ea);
      }
    }
    else if (ph == 14) {
      for (int row = gw; row < NL; row += NW) {
        const int t = row & 2047, grp = lane >> 5, ii = lane & 31;
        bf16_t* a = P + (size_t)row * PLD + 512 + grp * 64 + ii;
        const f32x2 cs = CS64[t * 32 + ii];
        const float x1 = bf2f(a[0]), x2 = bf2f(a[32]);
        a[0] = f2bf(x1 * cs.x - x2 * cs.y); a[32] = f2bf(x1 * cs.y + x2 * cs.x);
      }
      const float* hw = pp->in[21]; const float* hb = pp->in[22];
      float* us = (float*)smem;
      for (int item = bid; item < 32 * 32 * 24; item += G) {
        const int ct = item % 24, tt = (item / 24) & 31, b = item / 768;
        const int t0 = tt * 64;
        __syncthreads();
#pragma unroll
        for (int i = 0; i < 3; ++i) {
          const int id = tid + 256 * i;
          if (id < 528) {
            const int rr = id >> 3, ch8 = (id & 7) * 8, t = t0 - 1 + rr;
            u32x4 v = {0u, 0u, 0u, 0u};
            if (t >= 0 && t < 2048) v = __builtin_nontemporal_load((const GAS u32x4*)(P + (size_t)(b * 2048 + t) * PLD + 768 + ct * 64 + ch8));
            float* d = us + rr * 65 + ch8;
            d[0] = bflo(v.x); d[1] = bfhi(v.x); d[2] = bflo(v.y); d[3] = bfhi(v.y); d[4] = bflo(v.z); d[5] = bfhi(v.z); d[6] = bflo(v.w); d[7] = bfhi(v.w);
          }
        }
        __syncthreads();
#pragma unroll
        for (int k = 0; k < 2; ++k) {
          const int id = tid + 256 * k, ch = id >> 3, t8 = id & 7, cgl = ct * 64 + ch;
          const float w0 = hw[cgl], w1 = hw[1536 + cgl], w2 = hw[3072 + cgl], bb = hb[cgl];
          float v[8];
#pragma unroll
          for (int e = 0; e < 8; ++e) { const int tl = t8 * 8 + e; v[e] = w0 * us[tl * 65 + ch] + w1 * us[(tl + 1) * 65 + ch] + w2 * us[(tl + 2) * 65 + ch] + bb; }
          u32x4 w; w.x = pk2(v[0], v[1]); w.y = pk2(v[2], v[3]); w.z = pk2(v[4], v[5]); w.w = pk2(v[6], v[7]);
          *(GAS u32x4*)(HT + (size_t)cgl * 65536 + b * 2048 + t0 + t8 * 8) = w;
        }
      }
    }
    else if (ph == 15 || ph == 16) {
      const int order = ph - 15;
      const bf16_t* GARR = (const bf16_t*)(ws + OFF_GARR);
      const float* hbias = pp->in[30];
      const int nitems = (ph == 15) ? (2048 + 4096) : 2048;
      for (int j = slot; j < nitems / NX; j += nslot) {
        const int item = (j < 2048 / NX) ? xcd_item(j, xcd, NX, 4) : 2048 + xcd_item(j - 2048 / NX, xcd, NX, 64);
        if (item < 2048) {
          const int ch = item >> 2, tq = item & 3;
          const bf16_t* zin = (order == 0) ? HT + (size_t)ch * 65536 : Z1T + (size_t)ch * 65536;
          const bf16_t* xg = HT + (size_t)((order + 1) * 512 + ch) * 65536;
          bf16_t* zo = ((order == 0) ? Z1T : Z2T) + (size_t)ch * 65536;
          hyena_item(smem, zin, xg, GARR + (size_t)(order * 512 + ch) * 4096, hbias[order * 512 + ch], zo, tq, tid);
        } else {
          const int idx = item - 2048, b = idx >> 7, hq = (idx >> 4) & 7, qn = idx & 15, hk = hq >> 2;
          const int r = lane & 31, h = lane >> 5;
          const int qr = b * 2048 + qn * 128 + wid * 32 + r;
          bf16x8 qf[4];
          load_q<64, 0, 64>(qf, P + (size_t)qr * PLD + hq * 64, h, true, CS64 + (size_t)(qr & 2047) * 32);
          f32x16 O[2];
#pragma unroll
          for (int t = 0; t < 2; ++t)
#pragma unroll
            for (int e = 0; e < 16; ++e) O[t][e] = 0.f;
          float m = -1e30f, l = 0.f;
          const float c = 0.125f * 1.4426950408889634f;
          const bf16_t* kp = P + 512 + hk * 64; const bf16_t* vp = P + 640 + hk * 64;
          attn_pass<64, 64, 64, 2>(smem, qf, kp, PLD, kp, PLD, vp, PLD, b, qn, 0, c, O, m, l, tid);
          l += __shfl_xor(l, 32);
          l += __builtin_amdgcn_exp2f(pp->in[20][hq] * 1.4426950408889634f - m * c);
          attn_store<2>(O, 1.f / l, MI + (size_t)qr * 1024 + hq * 64, h);
        }
      }
    }
    else if (ph == 17) {
      bf16_t* tl = (bf16_t*)smem;
      for (int item = bid; item < 1024 * 8; item += G) {
        const int ct = item & 7, rt = item >> 3, r0 = rt * 64;
        __syncthreads();
#pragma unroll
        for (int u = 0; u < 2; ++u) { const int id = tid + 256 * u, ch = id >> 3, r8 = (id & 7) * 8;
          *(u32x4*)(tl + ch * 72 + r8) = __builtin_nontemporal_load((const GAS u32x4*)(Z2T + (size_t)(ct * 64 + ch) * 65536 + r0 + r8)); }
        __syncthreads();
#pragma unroll
        for (int u = 0; u < 2; ++u) { const int id = tid + 256 * u, rr = id >> 3, c8 = (id & 7) * 8;
          unsigned short v[8];
#pragma unroll
          for (int e = 0; e < 8; ++e) v[e] = tl[(c8 + e) * 72 + rr];
          u32x4 w; w.x = v[0] | ((unsigned)v[1] << 16); w.y = v[2] | ((unsigned)v[3] << 16); w.z = v[4] | ((unsigned)v[5] << 16); w.w = v[6] | ((unsigned)v[7] << 16);
          *(GAS u32x4*)(MI + (size_t)(r0 + rr) * 1024 + 512 + ct * 64 + c8) = w; }
      }
    }
#ifdef PROBE_MASK
    if (((PROBE_MASK >> ph) & 1) && !rep_done) { rep_done = true; xcd_barrier(xbar, xb_x, (volatile LAS unsigned*)&xb_words); --ph; continue; }
    rep_done = false;
#endif
    if (ph + 1 < p.ph_hi && ph != 4) {
      if (p.ph_hi > NPH) grid.sync();
      xcd_barrier(xbar, xb_x, (volatile LAS unsigned*)&xb_words);
    }
  }
}

extern "C" void kernel_launch(void* const* d_in, const int* in_sizes, int n_in, void* d_out, int out_size, void* d_ws, size_t ws_size, hipStream_t stream) {
  static int grid_blocks = 0;
  if (!grid_blocks) {
    int dev = 0, cus = 0, per_cu = 0;
    hipGetDevice(&dev);
    hipDeviceGetAttribute(&cus, hipDeviceAttributeMultiprocessorCount, dev);
    hipFuncSetAttribute((const void*)fwd_kernel, hipFuncAttributeMaxDynamicSharedMemorySize, SMEM_BYTES);
    hipOccupancyMaxActiveBlocksPerMultiprocessor(&per_cu, (const void*)fwd_kernel, 256, SMEM_BYTES);
    per_cu = 2;
    grid_blocks = cus * per_cu;
    if (ws_size < WS_END) fprintf(stderr, "kernel_launch: workspace too small: %zu < %zu\n", ws_size, (size_t)WS_END);
  }
  hipMemsetAsync((char*)d_ws + OFF_MOD, 0, MOD_BYTES + BAR_BYTES, stream);
  Params p{};
  for (int i = 0; i < 31; ++i) p.in[i] = (const float*)d_in[i];
  p.out = (float*)d_out; p.ws = (char*)d_ws;
#if MULTI_LAUNCH
  for (int ph = 0; ph < NPH; ++ph) {
    if (ph == 5) continue;
    p.ph_lo = ph; p.ph_hi = ph + 1;
    hipLaunchKernelGGL(fwd_kernel, dim3(grid_blocks), dim3(256), SMEM_BYTES, stream, p);
  }
#else
  p.ph_lo = 0; p.ph_hi = NPH;
  void* args[] = {&p};
  hipError_t e = hipLaunchCooperativeKernel((void*)fwd_kernel, dim3(grid_blocks), dim3(256), args, SMEM_BYTES, stream);
  if (e != hipSuccess) fprintf(stderr, "cooperative launch failed: %s (grid %d)\n", hipGetErrorString(e), grid_blocks);
#endif
}
```

```cpp
#include <hip/hip_runtime.h>
#include <hip/hip_cooperative_groups.h>
#include <stdint.h>
#include <stdio.h>
namespace cg = cooperative_groups;


#ifndef MULTI_LAUNCH
#define MULTI_LAUNCH 0
#endif

#define DI __device__ __forceinline__
#define GAS __attribute__((address_space(1)))
#define LAS __attribute__((address_space(3)))
typedef unsigned short bf16_t;
typedef short bf16x8 __attribute__((ext_vector_type(8)));
typedef short s16x4 __attribute__((ext_vector_type(4)));
typedef float f32x16 __attribute__((ext_vector_type(16)));
typedef float f32x4 __attribute__((ext_vector_type(4)));
typedef float f32x2 __attribute__((ext_vector_type(2)));
typedef unsigned u32x4 __attribute__((ext_vector_type(4)));
typedef unsigned u32x2 __attribute__((ext_vector_type(2)));
typedef __bf16 bf2_t __attribute__((ext_vector_type(2)));

constexpr int NL = 65536, NC = 8192, NT = NL + NC;
constexpr int SMEM_BYTES = 76800;
constexpr int NPH = 24;
constexpr int PLD = 2304;
constexpr int PE_CQ = 0, PE_CKV = 384, PE_DQ = 640, PE_DK = 1152, PE_DV = 1664, PE_KR = 2176;

constexpr size_t OFF_WT_IN0 = 0;
constexpr size_t OFF_WT_UQ  = OFF_WT_IN0 + 4718592;
constexpr size_t OFF_WT_UKV = OFF_WT_UQ + 589824;
constexpr size_t OFF_WT_OUT0 = OFF_WT_UKV + 524288;
constexpr size_t OFF_WT_OUT1 = OFF_WT_OUT0 + 2097152;
constexpr size_t OFF_WT_UP0 = OFF_WT_OUT1 + 2097152;
constexpr size_t OFF_WT_UP1 = OFF_WT_UP0 + 11534336;
constexpr size_t OFF_WT_DN0 = OFF_WT_UP1 + 11534336;
constexpr size_t OFF_WT_DN1 = OFF_WT_DN0 + 5767168;
constexpr size_t OFF_WT_IN1 = OFF_WT_DN1 + 5767168;
constexpr size_t OFF_MOD = OFF_WT_IN1 + 4718592;
constexpr size_t MOD_BYTES = 2 * 33 * 6144 * 4;
constexpr size_t OFF_BAR = OFF_MOD + MOD_BYTES;
constexpr size_t BAR_BYTES = 13824;
constexpr size_t OFF_CS64 = OFF_BAR + BAR_BYTES;
constexpr size_t OFF_CS32 = OFF_CS64 + 524288;
constexpr size_t OFF_GARR = OFF_CS32 + 262144;
constexpr size_t OFF_XC = OFF_GARR + 8388608 + 4096;
constexpr size_t OFF_H = OFF_XC + 33554432;
constexpr size_t OFF_P = OFF_H + 150994944;
constexpr size_t OFF_Q = OFF_P + 339738624;
constexpr size_t OFF_KV = OFF_Q + 113246208;
constexpr size_t OFF_MI = OFF_KV + 150994944;
constexpr size_t WS_END = OFF_MI + 150994944;
static_assert(WS_END <= (size_t)1073741824, "workspace");
constexpr size_t OFF_Y = OFF_KV;
constexpr size_t OFF_G = OFF_P;
constexpr size_t OFF_BND = OFF_MI;
constexpr size_t OFF_HT = OFF_Q;
constexpr size_t OFF_Z1T = OFF_H;
constexpr size_t OFF_Z2T = OFF_H + 67108864;

struct Params { const float* in[31]; float* out; char* ws; int ph_lo, ph_hi; };
typedef const __attribute__((address_space(4))) Params KParams;

DI unsigned pk2(float a, float b) { f32x2 v = {a, b}; bf2_t r = __builtin_convertvector(v, bf2_t); return __builtin_bit_cast(unsigned, r); }
DI float bflo(unsigned w) { return __uint_as_float(w << 16); }
DI float bfhi(unsigned w) { return __uint_as_float(w & 0xffff0000u); }
DI float bf2f(unsigned short v) { return __uint_as_float(((unsigned)v) << 16); }
DI unsigned short f2bf(float x) { return (unsigned short)(pk2(x, 0.f) & 0xffffu); }
DI float wave_sum(float v) {
#pragma unroll
  for (int o = 32; o > 0; o >>= 1) v += __shfl_xor(v, o);
  return v;
}
DI float siluf(float v) { return v / (1.f + __expf(-v)); }
DI f32x16 mfma32(bf16x8 a, bf16x8 b, f32x16 c) { return __builtin_amdgcn_mfma_f32_32x32x16_bf16(a, b, c, 0, 0, 0); }
DI int crow(int reg, int h) { return (reg & 3) + 8 * (reg >> 2) + 4 * h; }

DI void gemm_tile_to_lds(const bf16_t* __restrict__ A, int lda, const bf16_t* __restrict__ Bt, int K, int m0, int n0, char* smem, int tid) {
  const int lane = tid & 63, wid = tid >> 6, wr = wid >> 1, wc = wid & 1;
  const int srow = tid >> 3, sc = tid & 7;
  const bf16_t* ap = A + (size_t)(m0 + srow) * lda + sc * 8;
  const bf16_t* bp = Bt + (size_t)(n0 + srow) * K + sc * 8;
  const size_t astep = (size_t)32 * lda, bstep = (size_t)32 * K;
  const int st_off = srow * 144 + sc * 16;
  const int a_rd = (wr * 64 + (lane & 31)) * 144 + (lane >> 5) * 16;
  const int b_rd = 18432 + (wc * 64 + (lane & 31)) * 144 + (lane >> 5) * 16;
  f32x16 acc[2][2];
#pragma unroll
  for (int i = 0; i < 2; ++i)
#pragma unroll
    for (int j = 0; j < 2; ++j)
#pragma unroll
      for (int e = 0; e < 16; ++e) acc[i][j][e] = 0.f;
  u32x4 ra0[4], rb0[4], ra1[4], rb1[4];
  const int nk = K >> 6;
#pragma unroll
  for (int i = 0; i < 4; ++i) { ra0[i] = *(const GAS u32x4*)(ap + i * astep); rb0[i] = *(const GAS u32x4*)(bp + i * bstep); }
#pragma unroll
  for (int i = 0; i < 4; ++i) { ra1[i] = *(const GAS u32x4*)(ap + i * astep + 64); rb1[i] = *(const GAS u32x4*)(bp + i * bstep + 64); }
#pragma unroll
  for (int i = 0; i < 4; ++i) { *(u32x4*)(smem + st_off + i * 4608) = ra0[i]; *(u32x4*)(smem + 18432 + st_off + i * 4608) = rb0[i]; }
  __syncthreads();
#define GEMM_STEP(CUR, NXT, RL_A, RL_B, RS_A, RS_B, KLOAD) do { \
    const int kl_ = ((KLOAD) < nk) ? (KLOAD) : (nk - 1); \
    _Pragma("unroll") for (int i = 0; i < 4; ++i) { RL_A[i] = *(const GAS u32x4*)(ap + i * astep + kl_ * 64); RL_B[i] = *(const GAS u32x4*)(bp + i * bstep + kl_ * 64); } \
    bf16x8 af[4][2], bfr[4][2]; \
    _Pragma("unroll") for (int kk = 0; kk < 4; ++kk) { \
      af[kk][0] = *(const bf16x8*)((CUR) + a_rd + kk * 32); af[kk][1] = *(const bf16x8*)((CUR) + a_rd + 4608 + kk * 32); \
      bfr[kk][0] = *(const bf16x8*)((CUR) + b_rd + kk * 32); bfr[kk][1] = *(const bf16x8*)((CUR) + b_rd + 4608 + kk * 32); } \
    _Pragma("unroll") for (int kk = 0; kk < 4; ++kk) { \
      acc[0][0] = mfma32(af[kk][0], bfr[kk][0], acc[0][0]); acc[0][1] = mfma32(af[kk][0], bfr[kk][1], acc[0][1]); \
      acc[1][0] = mfma32(af[kk][1], bfr[kk][0], acc[1][0]); acc[1][1] = mfma32(af[kk][1], bfr[kk][1], acc[1][1]); } \
    _Pragma("unroll") for (int i = 0; i < 4; ++i) { *(u32x4*)((NXT) + st_off + i * 4608) = RS_A[i]; *(u32x4*)((NXT) + 18432 + st_off + i * 4608) = RS_B[i]; } \
    __builtin_amdgcn_sched_group_barrier(0x020, 8, 0); \
    __builtin_amdgcn_sched_group_barrier(0x100, 4, 0); \
    _Pragma("unroll") for (int q = 0; q < 12; ++q) { __builtin_amdgcn_sched_group_barrier(0x008, 1, 0); __builtin_amdgcn_sched_group_barrier(0x100, 1, 0); } \
    __builtin_amdgcn_sched_group_barrier(0x008, 4, 0); \
    __builtin_amdgcn_sched_group_barrier(0x200, 8, 0); \
    __syncthreads(); } while (0)
  for (int kt = 0; kt < nk; kt += 2) {
    GEMM_STEP(smem, smem + 36864, ra0, rb0, ra1, rb1, kt + 2);
    GEMM_STEP(smem + 36864, smem, ra1, rb1, ra0, rb0, kt + 3);
  }
#undef GEMM_STEP
  float* Cs = (float*)smem;
  const int h = lane >> 5, cl = lane & 31;
#pragma unroll
  for (int i = 0; i < 2; ++i)
#pragma unroll
    for (int j = 0; j < 2; ++j)
#pragma unroll
      for (int e = 0; e < 16; ++e) Cs[(wr * 64 + i * 32 + crow(e, h)) * 132 + wc * 64 + j * 32 + cl] = acc[i][j][e];
  __syncthreads();
}

DI void epi_bf16(const char* smem, bf16_t* __restrict__ out, int ldo, int m0, int n0, int tid) {
  const float* Cs = (const float*)smem;
#pragma unroll
  for (int i = 0; i < 8; ++i) {
    const int id = tid + 256 * i, r = id >> 4, c8 = (id & 15) * 8;
    const f32x4 v0 = *(const f32x4*)(Cs + r * 132 + c8), v1 = *(const f32x4*)(Cs + r * 132 + c8 + 4);
    u32x4 w; w.x = pk2(v0[0], v0[1]); w.y = pk2(v0[2], v0[3]); w.z = pk2(v1[0], v1[1]); w.w = pk2(v1[2], v1[3]);
    *(GAS u32x4*)(out + (size_t)(m0 + r) * ldo + n0 + c8) = w;
  }
  __syncthreads();
}

DI void epi_ffn(const char* smem, bf16_t* __restrict__ G, float* __restrict__ BND, const float* __restrict__ cw, const float* __restrict__ cb, int mt, int nt, int tid) {
  const float* Cs = (const float*)smem;
  const int m0 = mt * 128;
  const int L = (mt < 512) ? 2048 : 256;
  const bool first = (m0 % L) == 0, last = ((m0 + 128) % L) == 0;
  const int ja0 = nt * 64;
#pragma unroll
  for (int i = 0; i < 4; ++i) {
    const int id = tid + 256 * i, r = id >> 3, j8 = (id & 7) * 8;
    const bool top = (r == 0), bot = (r == 127);
    if ((top && !first) || (bot && !last)) continue;
    float res[8];
#pragma unroll
    for (int hh = 0; hh < 2; ++hh) {
      const int ja = ja0 + j8 + hh * 4;
      const f32x4 z4 = {0.f, 0.f, 0.f, 0.f};
      const int ca = j8 + hh * 4, cg_ = 64 + j8 + hh * 4;
      f32x4 ua, ug;
      {
        const f32x4 w0 = *(const GAS f32x4*)(cw + ja), w1 = *(const GAS f32x4*)(cw + 5632 + ja), w2 = *(const GAS f32x4*)(cw + 11264 + ja), bb = *(const GAS f32x4*)(cb + ja);
        const f32x4 pv = top ? z4 : *(const f32x4*)(Cs + (r - 1) * 132 + ca), cu = *(const f32x4*)(Cs + r * 132 + ca), nx = bot ? z4 : *(const f32x4*)(Cs + (r + 1) * 132 + ca);
        ua = w0 * pv + w1 * cu + w2 * nx + bb;
      }
      __builtin_amdgcn_sched_barrier(0);
      {
        const f32x4 w0 = *(const GAS f32x4*)(cw + 2816 + ja), w1 = *(const GAS f32x4*)(cw + 5632 + 2816 + ja), w2 = *(const GAS f32x4*)(cw + 11264 + 2816 + ja), bb = *(const GAS f32x4*)(cb + 2816 + ja);
        const f32x4 pv = top ? z4 : *(const f32x4*)(Cs + (r - 1) * 132 + cg_), cu = *(const f32x4*)(Cs + r * 132 + cg_), nx = bot ? z4 : *(const f32x4*)(Cs + (r + 1) * 132 + cg_);
        ug = w0 * pv + w1 * cu + w2 * nx + bb;
      }
#pragma unroll
      for (int e = 0; e < 4; ++e) res[hh * 4 + e] = siluf(ug[e]) * ua[e];
      __builtin_amdgcn_sched_barrier(0);
    }
    u32x4 w; w.x = pk2(res[0], res[1]); w.y = pk2(res[2], res[3]); w.z = pk2(res[4], res[5]); w.w = pk2(res[6], res[7]);
    *(GAS u32x4*)(G + (size_t)(m0 + r) * 2816 + ja0 + j8) = w;
  }
  if (tid < 128) {
    const int q = tid >> 5, c4 = (tid & 31) * 4;
    const int r = (q == 0) ? 0 : (q == 1) ? 1 : (q == 2) ? 126 : 127;
    const f32x4 v = *(const f32x4*)(Cs + r * 132 + c4);
    *(GAS f32x4*)(BND + ((size_t)(mt * 4 + q)) * 5632 + nt * 128 + c4) = v;
  }
  __syncthreads();
}

struct EpiArgs { bf16_t* out; int ldo; float* bnd; const float* cw; const float* cb; };
template <int EPI, int VAR = 0>
DI void gemm_tile256(const bf16_t* __restrict__ A, int lda, const bf16_t* __restrict__ Bt, int K, int mt, int nt, char* smem, int tid_in, const EpiArgs& ea) {
  int tid = tid_in; asm volatile("" : "+v"(tid));
  const int lane = tid & 63, wid = __builtin_amdgcn_readfirstlane(tid >> 6), wr = wid >> 1, wc = wid & 1;
  const int m0 = mt * 128, n0 = nt * 256;
  const int r = lane & 31, h = lane >> 5, key = (r >> 2) & 3;
  constexpr int STG = 24576;
  const int rowl = lane >> 2, cch = (lane & 3) ^ ((lane >> 4) & 3);
  const unsigned voffA = (unsigned)(rowl * lda * 2 + cch * 16), voffB = (unsigned)(rowl * K * 2 + cch * 16);
  const char* Abase = (const char*)(A + (size_t)m0 * lda) + (size_t)(wid * 2) * 32 * lda;
  const char* Bbase = (const char*)(Bt + (size_t)n0 * K) + (size_t)(wid * 4) * 32 * K;
  const size_t ablk = (size_t)32 * lda, bblk = (size_t)32 * K;
  LAS char* lds = (LAS char*)smem;
  LAS char* ldsA = lds + (wid * 2) * 1024;
  LAS char* ldsB = lds + 8192 + (wid * 4) * 1024;
#define DMA_STEP_(k, soff) do { \
    _Pragma("unroll") for (int q_ = 0; q_ < 2; ++q_) __builtin_amdgcn_global_load_lds((const GAS unsigned*)(Abase + q_ * ablk + (size_t)(k) * 64 + voffA), (LAS unsigned*)(ldsA + (soff) + q_ * 1024), 16, 0, 0); \
    _Pragma("unroll") for (int q_ = 0; q_ < 4; ++q_) __builtin_amdgcn_global_load_lds((const GAS unsigned*)(Bbase + q_ * bblk + (size_t)(k) * 64 + voffB), (LAS unsigned*)(ldsB + (soff) + q_ * 1024), 16, 0, 0); } while (0)
  const int x0 = ((0 + h) ^ key) * 16, x1 = ((2 + h) ^ key) * 16;
  const int a_rd = (wr * 64 + r) * 64, b_rd = 8192 + (wc * 128 + r) * 64;
  f32x16 acc[2][4];
#pragma unroll
  for (int i = 0; i < 2; ++i)
#pragma unroll
    for (int j = 0; j < 4; ++j)
#pragma unroll
      for (int e = 0; e < 16; ++e) acc[i][j][e] = 0.f;
  const int nk = K >> 5;
  DMA_STEP_(0, 0);
  DMA_STEP_(1, STG);
  asm volatile("s_waitcnt vmcnt(6)" ::: "memory");
  __builtin_amdgcn_s_barrier();
  asm volatile("" ::: "memory");
  int s0 = 0, s2 = 2 * STG;
  for (int kt = 0; kt < nk; ++kt) {
    const int kn = (kt + 2 < nk) ? (kt + 2) : (nk - 1);
    const LAS char* cur = lds + s0;
    bf16x8 af[2][2], bfr[2][4];
#pragma unroll
    for (int kk = 0; kk < 2; ++kk) {
      const int xo = kk ? x1 : x0;
      af[kk][0] = *(const LAS bf16x8*)(cur + a_rd + xo);
      bfr[kk][0] = *(const LAS bf16x8*)(cur + b_rd + xo);
      bfr[kk][1] = *(const LAS bf16x8*)(cur + b_rd + 2048 + xo);
      af[kk][1] = *(const LAS bf16x8*)(cur + a_rd + 2048 + xo);
      bfr[kk][2] = *(const LAS bf16x8*)(cur + b_rd + 4096 + xo);
      bfr[kk][3] = *(const LAS bf16x8*)(cur + b_rd + 6144 + xo);
    }
    DMA_STEP_(kn, s2);
#pragma unroll
    for (int kk = 0; kk < 2; ++kk) {
      acc[0][0] = mfma32(bfr[kk][0], af[kk][0], acc[0][0]); acc[0][1] = mfma32(bfr[kk][1], af[kk][0], acc[0][1]);
      acc[1][0] = mfma32(bfr[kk][0], af[kk][1], acc[1][0]); acc[1][1] = mfma32(bfr[kk][1], af[kk][1], acc[1][1]);
      acc[0][2] = mfma32(bfr[kk][2], af[kk][0], acc[0][2]); acc[0][3] = mfma32(bfr[kk][3], af[kk][0], acc[0][3]);
      acc[1][2] = mfma32(bfr[kk][2], af[kk][1], acc[1][2]); acc[1][3] = mfma32(bfr[kk][3], af[kk][1], acc[1][3]);
    }
    __builtin_amdgcn_sched_group_barrier(0x100, 12, 0);
    __builtin_amdgcn_sched_group_barrier(0x010, 6, 0);
    __builtin_amdgcn_sched_group_barrier(0x008, 16, 0);
    asm volatile("s_waitcnt vmcnt(6) lgkmcnt(0)" ::: "memory");
    __builtin_amdgcn_s_barrier();
    asm volatile("" ::: "memory");
    s0 = (s0 == 2 * STG) ? 0 : s0 + STG;
    s2 = (s2 == 2 * STG) ? 0 : s2 + STG;
  }
  asm volatile("s_waitcnt vmcnt(0)" ::: "memory");
  __builtin_amdgcn_s_barrier();
  asm volatile("" ::: "memory");
#undef DMA_STEP_
  {
    const int h = lane >> 5, cl = lane & 31;
#pragma unroll
    for (int i = 0; i < 2; ++i)
#pragma unroll
      for (int j = 0; j < 4; ++j)
#pragma unroll
        for (int g = 0; g < 4; ++g) {
          u32x2 w; w.x = pk2(acc[i][j][4 * g], acc[i][j][4 * g + 1]); w.y = pk2(acc[i][j][4 * g + 2], acc[i][j][4 * g + 3]);
          *(u32x2*)(smem + (wr * 64 + i * 32 + cl) * 528 + (wc * 128 + j * 32 + 8 * g + 4 * h) * 2) = w;
        }
  }
  __syncthreads();
  int tid2 = tid; asm volatile("" : "+v"(tid2));
  if (EPI == 0) {
#pragma unroll
    for (int i = 0; i < 16; ++i) {
      const int id = tid2 + 256 * i, r = id >> 5, c8 = (id & 31) * 8;
      const u32x4 v = *(const u32x4*)(smem + r * 528 + c8 * 2);
      *(GAS u32x4*)(ea.out + (size_t)(m0 + r) * ea.ldo + n0 + c8) = v;
    }
  } else {
    const int L = (mt < 512) ? 2048 : 256;
    const bool first = (m0 % L) == 0, last = ((m0 + 128) % L) == 0;
    const float* cw = ea.cw; const float* cb = ea.cb;
#pragma unroll 1
    for (int p = 0; p < 2; ++p) {
      const int j8 = (tid2 & 7) * 8;
      const int ja0 = (nt * 2 + p) * 64, ja = ja0 + j8;
      f32x4 wa[4][2], wg[4][2];
#pragma unroll
      for (int hh = 0; hh < 2; ++hh) {
        wa[0][hh] = *(const GAS f32x4*)(cw + ja + 4 * hh); wa[1][hh] = *(const GAS f32x4*)(cw + 5632 + ja + 4 * hh); wa[2][hh] = *(const GAS f32x4*)(cw + 11264 + ja + 4 * hh); wa[3][hh] = *(const GAS f32x4*)(cb + ja + 4 * hh);
        wg[0][hh] = *(const GAS f32x4*)(cw + 2816 + ja + 4 * hh); wg[1][hh] = *(const GAS f32x4*)(cw + 5632 + 2816 + ja + 4 * hh); wg[2][hh] = *(const GAS f32x4*)(cw + 11264 + 2816 + ja + 4 * hh); wg[3][hh] = *(const GAS f32x4*)(cb + 2816 + ja + 4 * hh);
      }
#pragma unroll 1
      for (int i = 0; i < 4; ++i) {
        const int r = (tid2 + 256 * i) >> 3;
        const bool top = (r == 0), bot = (r == 127);
        if ((top && !first) || (bot && !last)) continue;
        const char* base = smem + r * 528 + (p * 128 + j8) * 2;
        const u32x4 zz = {0u, 0u, 0u, 0u};
        const u32x4 pa = top ? zz : *(const u32x4*)(base - 528), ca = *(const u32x4*)base, na = bot ? zz : *(const u32x4*)(base + 528);
        const u32x4 pg = top ? zz : *(const u32x4*)(base - 528 + 128), cg = *(const u32x4*)(base + 128), ng = bot ? zz : *(const u32x4*)(base + 528 + 128);
        unsigned resw[4];
#pragma unroll
        for (int q = 0; q < 4; ++q) {
          const int hh = q >> 1, e0 = (q & 1) * 2;
          const float ua0 = wa[0][hh][e0] * bflo(pa[q]) + wa[1][hh][e0] * bflo(ca[q]) + wa[2][hh][e0] * bflo(na[q]) + wa[3][hh][e0];
          const float ua1 = wa[0][hh][e0 + 1] * bfhi(pa[q]) + wa[1][hh][e0 + 1] * bfhi(ca[q]) + wa[2][hh][e0 + 1] * bfhi(na[q]) + wa[3][hh][e0 + 1];
          const float ug0 = wg[0][hh][e0] * bflo(pg[q]) + wg[1][hh][e0] * bflo(cg[q]) + wg[2][hh][e0] * bflo(ng[q]) + wg[3][hh][e0];
          const float ug1 = wg[0][hh][e0 + 1] * bfhi(pg[q]) + wg[1][hh][e0 + 1] * bfhi(cg[q]) + wg[2][hh][e0 + 1] * bfhi(ng[q]) + wg[3][hh][e0 + 1];
          resw[q] = pk2(siluf(ug0) * ua0, siluf(ug1) * ua1);
        }
        u32x4 w; w.x = resw[0]; w.y = resw[1]; w.z = resw[2]; w.w = resw[3];
        __builtin_nontemporal_store(w, (GAS u32x4*)(ea.out + (size_t)(m0 + r) * 2816 + ja0 + j8));
      }
    }
    {
      const int q = tid2 >> 6, c4 = (tid2 & 63) * 4;
      const int r = (q == 0) ? 0 : (q == 1) ? 1 : (q == 2) ? 126 : 127;
      const u32x2 v = *(const u32x2*)(smem + r * 528 + c4 * 2);
      const f32x4 o = {bflo(v.x), bfhi(v.x), bflo(v.y), bfhi(v.y)};
      *(GAS f32x4*)(ea.bnd + ((size_t)(mt * 4 + q)) * 5632 + nt * 256 + c4) = o;
    }
  }
  __syncthreads();
}

#define TRV_OUTS(R) "=&v"(R[0]), "=&v"(R[1]), "=&v"(R[2]), "=&v"(R[3]), "=&v"(R[4]), "=&v"(R[5]), "=&v"(R[6]), "=&v"(R[7]), "=&v"(R[8]), "=&v"(R[9]), "=&v"(R[10]), "=&v"(R[11]), "=&v"(R[12]), "=&v"(R[13]), "=&v"(R[14]), "=&v"(R[15])
#define TRV_OUTS8(R) "=&v"(R[0]), "=&v"(R[1]), "=&v"(R[2]), "=&v"(R[3]), "=&v"(R[4]), "=&v"(R[5]), "=&v"(R[6]), "=&v"(R[7])
#define TRV8_320_T0(R, addr) asm volatile( \
    "ds_read_b64_tr_b16 %0, %8 offset:0\n\t" \
    "ds_read_b64_tr_b16 %1, %8 offset:2560\n\t" \
    "ds_read_b64_tr_b16 %2, %8 offset:5120\n\t" \
    "ds_read_b64_tr_b16 %3, %8 offset:7680\n\t" \
    "ds_read_b64_tr_b16 %4, %8 offset:10240\n\t" \
    "ds_read_b64_tr_b16 %5, %8 offset:12800\n\t" \
    "ds_read_b64_tr_b16 %6, %8 offset:15360\n\t" \
    "ds_read_b64_tr_b16 %7, %8 offset:17920\n\t" \
    "s_waitcnt lgkmcnt(0)" : TRV_OUTS8(R) : "v"(addr) : "memory")
#define TRV8_320_T1(R, addr) asm volatile( \
    "ds_read_b64_tr_b16 %0, %8 offset:64\n\t" \
    "ds_read_b64_tr_b16 %1, %8 offset:2624\n\t" \
    "ds_read_b64_tr_b16 %2, %8 offset:5184\n\t" \
    "ds_read_b64_tr_b16 %3, %8 offset:7744\n\t" \
    "ds_read_b64_tr_b16 %4, %8 offset:10304\n\t" \
    "ds_read_b64_tr_b16 %5, %8 offset:12864\n\t" \
    "ds_read_b64_tr_b16 %6, %8 offset:15424\n\t" \
    "ds_read_b64_tr_b16 %7, %8 offset:17984\n\t" \
    "s_waitcnt lgkmcnt(0)" : TRV_OUTS8(R) : "v"(addr) : "memory")
#define TRV8_320_T2(R, addr) asm volatile( \
    "ds_read_b64_tr_b16 %0, %8 offset:128\n\t" \
    "ds_read_b64_tr_b16 %1, %8 offset:2688\n\t" \
    "ds_read_b64_tr_b16 %2, %8 offset:5248\n\t" \
    "ds_read_b64_tr_b16 %3, %8 offset:7808\n\t" \
    "ds_read_b64_tr_b16 %4, %8 offset:10368\n\t" \
    "ds_read_b64_tr_b16 %5, %8 offset:12928\n\t" \
    "ds_read_b64_tr_b16 %6, %8 offset:15488\n\t" \
    "ds_read_b64_tr_b16 %7, %8 offset:18048\n\t" \
    "s_waitcnt lgkmcnt(0)" : TRV_OUTS8(R) : "v"(addr) : "memory")
#define TRV8_320_T3(R, addr) asm volatile( \
    "ds_read_b64_tr_b16 %0, %8 offset:192\n\t" \
    "ds_read_b64_tr_b16 %1, %8 offset:2752\n\t" \
    "ds_read_b64_tr_b16 %2, %8 offset:5312\n\t" \
    "ds_read_b64_tr_b16 %3, %8 offset:7872\n\t" \
    "ds_read_b64_tr_b16 %4, %8 offset:10432\n\t" \
    "ds_read_b64_tr_b16 %5, %8 offset:12992\n\t" \
    "ds_read_b64_tr_b16 %6, %8 offset:15552\n\t" \
    "ds_read_b64_tr_b16 %7, %8 offset:18112\n\t" \
    "s_waitcnt lgkmcnt(0)" : TRV_OUTS8(R) : "v"(addr) : "memory")
#define TRV8_192_T0(R, addr) asm volatile( \
    "ds_read_b64_tr_b16 %0, %8 offset:0\n\t" \
    "ds_read_b64_tr_b16 %1, %8 offset:1536\n\t" \
    "ds_read_b64_tr_b16 %2, %8 offset:3072\n\t" \
    "ds_read_b64_tr_b16 %3, %8 offset:4608\n\t" \
    "ds_read_b64_tr_b16 %4, %8 offset:6144\n\t" \
    "ds_read_b64_tr_b16 %5, %8 offset:7680\n\t" \
    "ds_read_b64_tr_b16 %6, %8 offset:9216\n\t" \
    "ds_read_b64_tr_b16 %7, %8 offset:10752\n\t" \
    "s_waitcnt lgkmcnt(0)" : TRV_OUTS8(R) : "v"(addr) : "memory")
#define TRV8_192_T1(R, addr) asm volatile( \
    "ds_read_b64_tr_b16 %0, %8 offset:64\n\t" \
    "ds_read_b64_tr_b16 %1, %8 offset:1600\n\t" \
    "ds_read_b64_tr_b16 %2, %8 offset:3136\n\t" \
    "ds_read_b64_tr_b16 %3, %8 offset:4672\n\t" \
    "ds_read_b64_tr_b16 %4, %8 offset:6208\n\t" \
    "ds_read_b64_tr_b16 %5, %8 offset:7744\n\t" \
    "ds_read_b64_tr_b16 %6, %8 offset:9280\n\t" \
    "ds_read_b64_tr_b16 %7, %8 offset:10816\n\t" \
    "s_waitcnt lgkmcnt(0)" : TRV_OUTS8(R) : "v"(addr) : "memory")
#define TRV_READ_192_T0(R, addr) asm volatile( \
    "ds_read_b64_tr_b16 %0, %16 offset:0\n\t" \
    "ds_read_b64_tr_b16 %1, %16 offset:1536\n\t" \
    "ds_read_b64_tr_b16 %2, %16 offset:3072\n\t" \
    "ds_read_b64_tr_b16 %3, %16 offset:4608\n\t" \
    "ds_read_b64_tr_b16 %4, %16 offset:6144\n\t" \
    "ds_read_b64_tr_b16 %5, %16 offset:7680\n\t" \
    "ds_read_b64_tr_b16 %6, %16 offset:9216\n\t" \
    "ds_read_b64_tr_b16 %7, %16 offset:10752\n\t" \
    "ds_read_b64_tr_b16 %8, %16 offset:64\n\t" \
    "ds_read_b64_tr_b16 %9, %16 offset:1600\n\t" \
    "ds_read_b64_tr_b16 %10, %16 offset:3136\n\t" \
    "ds_read_b64_tr_b16 %11, %16 offset:4672\n\t" \
    "ds_read_b64_tr_b16 %12, %16 offset:6208\n\t" \
    "ds_read_b64_tr_b16 %13, %16 offset:7744\n\t" \
    "ds_read_b64_tr_b16 %14, %16 offset:9280\n\t" \
    "ds_read_b64_tr_b16 %15, %16 offset:10816\n\t" \
    "s_waitcnt lgkmcnt(0)" : TRV_OUTS(R) : "v"(addr) : "memory")
#define TRV_READ_320_T0(R, addr) asm volatile( \
    "ds_read_b64_tr_b16 %0, %16 offset:0\n\t" \
    "ds_read_b64_tr_b16 %1, %16 offset:2560\n\t" \
    "ds_read_b64_tr_b16 %2, %16 offset:5120\n\t" \
    "ds_read_b64_tr_b16 %3, %16 offset:7680\n\t" \
    "ds_read_b64_tr_b16 %4, %16 offset:10240\n\t" \
    "ds_read_b64_tr_b16 %5, %16 offset:12800\n\t" \
    "ds_read_b64_tr_b16 %6, %16 offset:15360\n\t" \
    "ds_read_b64_tr_b16 %7, %16 offset:17920\n\t" \
    "ds_read_b64_tr_b16 %8, %16 offset:64\n\t" \
    "ds_read_b64_tr_b16 %9, %16 offset:2624\n\t" \
    "ds_read_b64_tr_b16 %10, %16 offset:5184\n\t" \
    "ds_read_b64_tr_b16 %11, %16 offset:7744\n\t" \
    "ds_read_b64_tr_b16 %12, %16 offset:10304\n\t" \
    "ds_read_b64_tr_b16 %13, %16 offset:12864\n\t" \
    "ds_read_b64_tr_b16 %14, %16 offset:15424\n\t" \
    "ds_read_b64_tr_b16 %15, %16 offset:17984\n\t" \
    "s_waitcnt lgkmcnt(0)" : TRV_OUTS(R) : "v"(addr) : "memory")
#define TRV_READ_320_T2(R, addr) asm volatile( \
    "ds_read_b64_tr_b16 %0, %16 offset:128\n\t" \
    "ds_read_b64_tr_b16 %1, %16 offset:2688\n\t" \
    "ds_read_b64_tr_b16 %2, %16 offset:5248\n\t" \
    "ds_read_b64_tr_b16 %3, %16 offset:7808\n\t" \
    "ds_read_b64_tr_b16 %4, %16 offset:10368\n\t" \
    "ds_read_b64_tr_b16 %5, %16 offset:12928\n\t" \
    "ds_read_b64_tr_b16 %6, %16 offset:15488\n\t" \
    "ds_read_b64_tr_b16 %7, %16 offset:18048\n\t" \
    "ds_read_b64_tr_b16 %8, %16 offset:192\n\t" \
    "ds_read_b64_tr_b16 %9, %16 offset:2752\n\t" \
    "ds_read_b64_tr_b16 %10, %16 offset:5312\n\t" \
    "ds_read_b64_tr_b16 %11, %16 offset:7872\n\t" \
    "ds_read_b64_tr_b16 %12, %16 offset:10432\n\t" \
    "ds_read_b64_tr_b16 %13, %16 offset:12992\n\t" \
    "ds_read_b64_tr_b16 %14, %16 offset:15552\n\t" \
    "ds_read_b64_tr_b16 %15, %16 offset:18112\n\t" \
    "s_waitcnt lgkmcnt(0)" : TRV_OUTS(R) : "v"(addr) : "memory")

template <int MODE> DI int key_tile_row(int i, int b, int qn, int wlo) {
  if (i < 4) return NL + b * 256 + 64 * i;
  if (MODE == 0) return b * 2048 + 64 * (i - 4);
  return b * 2048 + (qn - 1) * 128 + 64 * (wlo + i - 4);
}

template <int DQK, int DV, int KW0, int WHICH>
DI void attn_gload(u32x4 (&kreg)[(64 * (DQK / 8)) / 256], u32x4 (&vreg)[(32 * (DV / 8)) / 256][2],
                   const bf16_t* __restrict__ k0p, int ldk0, const bf16_t* __restrict__ k1p, int ldk1, const bf16_t* __restrict__ vp, int ldv, int krow, int tid) {
  constexpr int KCH = DQK / 8, NKC = (64 * KCH) / 256, VCH = DV / 8, NVU = (32 * VCH) / 256;
  if (WHICH & 1)
#pragma unroll
  for (int i = 0; i < NKC; ++i) {
    const int id = tid + 256 * i, key = id / KCH, ch = id % KCH;
    const bf16_t* src;
    if constexpr (KW0 == DQK) src = (const bf16_t*)((const char*)(k0p + (size_t)krow * ldk0) + (unsigned)((key * ldk0 + ch * 8) * 2));
    else src = (ch * 8 < KW0) ? (k0p + (size_t)(krow + key) * ldk0 + ch * 8) : (k1p + (size_t)(krow + key) * ldk1 + (ch * 8 - KW0));
    kreg[i] = *(const GAS u32x4*)src;
  }
  if (WHICH & 2)
#pragma unroll
  for (int u = 0; u < NVU; ++u) {
    const int id = tid + 256 * u, kp = id / VCH, ch = id % VCH;
    const char* vb = (const char*)(vp + (size_t)krow * ldv);
    vreg[u][0] = *(const GAS u32x4*)(vb + (unsigned)((2 * kp * ldv + ch * 8) * 2));
    vreg[u][1] = *(const GAS u32x4*)(vb + (unsigned)(((2 * kp + 1) * ldv + ch * 8) * 2));
  }
}

template <int DQK, int DV>
DI void attn_sstore(const u32x4 (&kreg)[(64 * (DQK / 8)) / 256], const u32x4 (&vreg)[(32 * (DV / 8)) / 256][2], char* stage, int tid) {
  constexpr int KCH = DQK / 8, NKC = (64 * KCH) / 256, VCH = DV / 8, NVU = (32 * VCH) / 256, KS = DQK + 8, KB = 64 * KS * 2, VSB = DV * 2 + 64;
#pragma unroll
  for (int i = 0; i < NKC; ++i) {
    const int id = tid + 256 * i, key = id / KCH, ch = id % KCH;
    *(u32x4*)(stage + key * (KS * 2) + ch * 16) = kreg[i];
  }
#pragma unroll
  for (int u = 0; u < NVU; ++u) {
    const int id = tid + 256 * u, kp = id / VCH, ch = id % VCH;
    *(u32x4*)(stage + KB + (2 * kp) * VSB + ch * 16) = vreg[u][0];
    *(u32x4*)(stage + KB + (2 * kp + 1) * VSB + ch * 16) = vreg[u][1];
  }
}

template <int DQK, int DV, int KW0, int MODE>
DI void attn_pass(char* smem, const bf16x8 (&qf)[DQK / 16],
                  const bf16_t* __restrict__ k0p, int ldk0, const bf16_t* __restrict__ k1p, int ldk1, const bf16_t* __restrict__ vp, int ldv,
                  int b, int qn, int nkt0, float c, f32x16 (&O)[DV / 32], float& m_io, float& l_io, int tid) {
  constexpr int KS = DQK + 8, KB = 64 * KS * 2, VSB = DV * 2 + 64, VB = 64 * VSB, STG = KB + VB;
  constexpr int NKC = (64 * (DQK / 8)) / 256, NVU = (32 * (DV / 8)) / 256;
  static_assert(2 * STG <= SMEM_BYTES, "attn lds");
  const int lane = tid & 63, wid = tid >> 6, r = lane & 31, h = lane >> 5;
  int nkt, wlo = 0;
  if (MODE == 0) nkt = nkt0; else { wlo = (qn == 0) ? 2 : 0; const int whi = (qn == 15) ? 3 : 5; nkt = 4 + whi - wlo + 1; }
  u32x4 kreg[NKC]; u32x4 vreg[NVU][2];
  float m = m_io, l = l_io;
  constexpr bool QLDS = (DV > 64);
  static_assert(!QLDS || (2 * STG + 4 * (DQK / 16) * 1024 <= SMEM_BYTES), "attn q lds");
  char* qbase = smem + 2 * STG + (wid * (DQK / 16)) * 1024 + lane * 16;
  __syncthreads();
  if (QLDS) {
#pragma unroll
    for (int kk = 0; kk < DQK / 16; ++kk) *(bf16x8*)(qbase + kk * 1024) = qf[kk];
  }
  attn_gload<DQK, DV, KW0, 3>(kreg, vreg, k0p, ldk0, k1p, ldk1, vp, ldv, key_tile_row<MODE>(0, b, qn, wlo), tid);
  attn_sstore<DQK, DV>(kreg, vreg, smem, tid);
  __syncthreads();
  for (int it = 0; it < nkt; ++it) {
    const char* cur = smem + (it & 1) * STG;
    const bool more = (it + 1 < nkt);
    if (DV <= 64) { if (more) attn_gload<DQK, DV, KW0, 3>(kreg, vreg, k0p, ldk0, k1p, ldk1, vp, ldv, key_tile_row<MODE>(it + 1, b, qn, wlo), tid); __builtin_amdgcn_sched_barrier(0); }
    f32x16 S0, S1;
#pragma unroll
    for (int e = 0; e < 16; ++e) { S0[e] = 0.f; S1[e] = 0.f; }
    {
      bf16x8 kfa[DQK / 16], kfb[DQK / 16], qv[DQK / 16];
#pragma unroll
      for (int kk = 0; kk < DQK / 16; ++kk) {
        kfa[kk] = *(const bf16x8*)(cur + r * (KS * 2) + kk * 32 + h * 16);
        kfb[kk] = *(const bf16x8*)(cur + (32 + r) * (KS * 2) + kk * 32 + h * 16);
        qv[kk] = QLDS ? *(const bf16x8*)(qbase + kk * 1024) : qf[kk];
      }
#pragma unroll
      for (int kk = 0; kk < DQK / 16; ++kk) {
        S0 = mfma32(kfa[kk], qv[kk], S0);
        S1 = mfma32(kfb[kk], qv[kk], S1);
      }
      __builtin_amdgcn_sched_group_barrier(0x100, (QLDS ? 3 : 2) * (DQK / 16), 0);
      __builtin_amdgcn_sched_group_barrier(0x008, 2 * (DQK / 16), 0);
    }
    if (MODE == 2) {
      if (it >= 4) {
        const int w = wlo + it - 4;
        if (w < 2 || w > 3) {
          const int kpos0 = (qn - 1) * 128 + 64 * w, qpos = qn * 128 + wid * 32 + r;
#pragma unroll
          for (int e = 0; e < 16; ++e) {
            const int d0 = qpos - (kpos0 + crow(e, h)), d1 = d0 - 32;
            if (d0 > 128 || d0 < -128) S0[e] = -1e30f;
            if (d1 > 128 || d1 < -128) S1[e] = -1e30f;
          }
        }
      }
    }
    float mx = S0[0];
#pragma unroll
    for (int e = 1; e < 16; ++e) mx = fmaxf(mx, S0[e]);
#pragma unroll
    for (int e = 0; e < 16; ++e) mx = fmaxf(mx, S1[e]);
    mx = fmaxf(mx, __shfl_xor(mx, 32));
    const float mn = fmaxf(m, mx);
    const bool grow = __builtin_amdgcn_ballot_w64(mx > m) != 0ull;
    const float alpha = __builtin_amdgcn_exp2f((m - mn) * c);
    m = mn;
    const float mc = mn * c;
    float ps = 0.f;
#pragma unroll
    for (int e = 0; e < 16; ++e) { S0[e] = __builtin_amdgcn_exp2f(S0[e] * c - mc); ps += S0[e]; }
#pragma unroll
    for (int e = 0; e < 16; ++e) { S1[e] = __builtin_amdgcn_exp2f(S1[e] * c - mc); ps += S1[e]; }
    if (grow) {
      l *= alpha;
#pragma unroll
      for (int t = 0; t < DV / 32; ++t)
#pragma unroll
        for (int e = 0; e < 16; ++e) O[t][e] *= alpha;
    }
    l += ps;
    bf16x8 pf[2][2];
#pragma unroll
    for (int s = 0; s < 2; ++s) {
      u32x4 w0, w1;
      w0.x = pk2(S0[8 * s + 0], S0[8 * s + 1]); w0.y = pk2(S0[8 * s + 2], S0[8 * s + 3]); w0.z = pk2(S0[8 * s + 4], S0[8 * s + 5]); w0.w = pk2(S0[8 * s + 6], S0[8 * s + 7]);
      w1.x = pk2(S1[8 * s + 0], S1[8 * s + 1]); w1.y = pk2(S1[8 * s + 2], S1[8 * s + 3]); w1.z = pk2(S1[8 * s + 4], S1[8 * s + 5]); w1.w = pk2(S1[8 * s + 6], S1[8 * s + 7]);
      pf[0][s] = __builtin_bit_cast(bf16x8, w0); pf[1][s] = __builtin_bit_cast(bf16x8, w1);
    }
    {
      const unsigned vaddr = (unsigned)(size_t)(cur + KB) + (unsigned)((4 * h + ((lane & 15) >> 2)) * VSB + ((lane >> 4) & 1) * 32 + (lane & 3) * 8);
      if (DV == 64) {
        s16x4 R[8];
#define PV_TILE64_(T) do { TRV8_192_T##T(R, vaddr); \
          _Pragma("unroll") for (int st = 0; st < 2; ++st) _Pragma("unroll") for (int s = 0; s < 2; ++s) { const int ix = (st * 2 + s) * 2; \
            const bf16x8 va = __builtin_shufflevector(R[ix], R[ix + 1], 0, 1, 2, 3, 4, 5, 6, 7); O[T] = mfma32(va, pf[st][s], O[T]); } } while (0)
        PV_TILE64_(0); PV_TILE64_(1);
#undef PV_TILE64_
      } else {
        s16x4 R[8];
#define PV_TILE_(T) do { TRV8_320_T##T(R, vaddr); \
          _Pragma("unroll") for (int st = 0; st < 2; ++st) _Pragma("unroll") for (int s = 0; s < 2; ++s) { const int ix = (st * 2 + s) * 2; \
            const bf16x8 va = __builtin_shufflevector(R[ix], R[ix + 1], 0, 1, 2, 3, 4, 5, 6, 7); O[(DV > 64) ? T : 0] = mfma32(va, pf[st][s], O[(DV > 64) ? T : 0]); } } while (0)
        PV_TILE_(0); PV_TILE_(1); PV_TILE_(2); PV_TILE_(3);
#undef PV_TILE_
      }
    }
    if (DV > 64) { __builtin_amdgcn_sched_barrier(0); if (more) attn_gload<DQK, DV, KW0, 3>(kreg, vreg, k0p, ldk0, k1p, ldk1, vp, ldv, key_tile_row<MODE>(it + 1, b, qn, wlo), tid); }
    if (more) attn_sstore<DQK, DV>(kreg, vreg, smem + ((it + 1) & 1) * STG, tid);
    __syncthreads();
  }
  m_io = m; l_io = l;
}

template <int DQK, int ROFF, int RDIM>
DI void load_q(bf16x8 (&qf)[DQK / 16], const bf16_t* __restrict__ qrowp, int h, bool rope, const f32x2* __restrict__ cs  ) {
#pragma unroll
  for (int kk = 0; kk < DQK / 16; ++kk) qf[kk] = *(const GAS bf16x8*)(qrowp + kk * 16 + h * 8);
  if (rope) {
    constexpr int NP = RDIM / 32;
#pragma unroll
    for (int p = 0; p < NP; ++p) {
      const int ka = ROFF / 16 + p, kb = ka + NP;
      bf16x8 xa = qf[ka], xb = qf[kb];
      u32x4 oa, ob;
#pragma unroll
      for (int j2 = 0; j2 < 4; ++j2) {
        float o1[2], o2[2];
#pragma unroll
        for (int q = 0; q < 2; ++q) {
          const int j = 2 * j2 + q;
          const f32x2 csv = cs[16 * p + 8 * h + j];
          const float x1 = bf2f((unsigned short)xa[j]), x2 = bf2f((unsigned short)xb[j]);
          o1[q] = x1 * csv.x - x2 * csv.y; o2[q] = x1 * csv.y + x2 * csv.x;
        }
        oa[j2] = pk2(o1[0], o1[1]); ob[j2] = pk2(o2[0], o2[1]);
      }
      qf[ka] = __builtin_bit_cast(bf16x8, oa); qf[kb] = __builtin_bit_cast(bf16x8, ob);
    }
  }
}

template <int NTL> DI void attn_store(const f32x16 (&O)[NTL], float inv, bf16_t* __restrict__ outp, int h) {
#pragma unroll
  for (int t = 0; t < NTL; ++t)
#pragma unroll
    for (int g = 0; g < 4; ++g) {
      u32x2 w; w.x = pk2(O[t][4 * g] * inv, O[t][4 * g + 1] * inv); w.y = pk2(O[t][4 * g + 2] * inv, O[t][4 * g + 3] * inv);
      *(GAS u32x2*)(outp + 32 * t + 8 * g + 4 * h) = w;
    }
}

struct RowIO4 { const float* xin; const bf16_t* y; const float* gate; float* xout; const float* shift; const float* scale; bf16_t* hout; };
DI void rw_rows4(const RowIO4& R, const float* __restrict__ ga, const float* __restrict__ gb, int lane) {
  f32x4 x[4][4]; u32x2 yr[4][4];
  f32x4 ga4[4], gt4[4], gb4[4], sh4[4], sc4[4];
#pragma unroll
  for (int r = 0; r < 4; ++r)
#pragma unroll
    for (int i = 0; i < 4; ++i) x[r][i] = __builtin_nontemporal_load((const GAS f32x4*)(R.xin + r * 1024 + 4 * lane + 256 * i));
  if (R.y) {
#pragma unroll
    for (int r = 0; r < 4; ++r)
#pragma unroll
      for (int i = 0; i < 4; ++i) yr[r][i] = *(const GAS u32x2*)(R.y + r * 1024 + 4 * lane + 256 * i);
#pragma unroll
    for (int i = 0; i < 4; ++i) { ga4[i] = *(const GAS f32x4*)(ga + 4 * lane + 256 * i); gt4[i] = *(const GAS f32x4*)(R.gate + 4 * lane + 256 * i); }
  }
  if (R.hout) {
#pragma unroll
    for (int i = 0; i < 4; ++i) { gb4[i] = *(const GAS f32x4*)(gb + 4 * lane + 256 * i); sh4[i] = *(const GAS f32x4*)(R.shift + 4 * lane + 256 * i); sc4[i] = *(const GAS f32x4*)(R.scale + 4 * lane + 256 * i); }
  }
#pragma unroll
  for (int r = 0; r < 4; ++r) {
    if (R.y) {
      f32x4 yv[4]; float ss = 0.f;
#pragma unroll
      for (int i = 0; i < 4; ++i) {
        yv[i] = (f32x4){bflo(yr[r][i].x), bfhi(yr[r][i].x), bflo(yr[r][i].y), bfhi(yr[r][i].y)};
        ss += yv[i][0] * yv[i][0] + yv[i][1] * yv[i][1] + yv[i][2] * yv[i][2] + yv[i][3] * yv[i][3];
      }
      const float rinv = rsqrtf(wave_sum(ss) * (1.f / 1024.f) + 1e-6f);
#pragma unroll
      for (int i = 0; i < 4; ++i) x[r][i] = x[r][i] + gt4[i] * (yv[i] * rinv * ga4[i]);
    }
    if (R.xout) {
#pragma unroll
      for (int i = 0; i < 4; ++i) __builtin_nontemporal_store(x[r][i], (GAS f32x4*)(R.xout + r * 1024 + 4 * lane + 256 * i));
    }
    if (R.hout) {
      float ss = 0.f;
#pragma unroll
      for (int i = 0; i < 4; ++i) ss += x[r][i][0] * x[r][i][0] + x[r][i][1] * x[r][i][1] + x[r][i][2] * x[r][i][2] + x[r][i][3] * x[r][i][3];
      const float rinv = rsqrtf(wave_sum(ss) * (1.f / 1024.f) + 1e-6f);
#pragma unroll
      for (int i = 0; i < 4; ++i) {
        const f32x4 hv = (x[r][i] * rinv * gb4[i]) * (sc4[i] + 1.f) + sh4[i];
        u32x2 w; w.x = pk2(hv[0], hv[1]); w.y = pk2(hv[2], hv[3]);
        *(GAS u32x2*)(R.hout + r * 1024 + 4 * lane + 256 * i) = w;
      }
    }
  }
}

DI void hyena_item(char* smem, const bf16_t* __restrict__ zin, const bf16_t* __restrict__ xg, const bf16_t* __restrict__ arr, float bias, bf16_t* __restrict__ zout, int tq, int tid) {
  constexpr int CSB = 5184;
  constexpr int ZOFF = 4 * CSB;
  constexpr int ZSB = 528;
  constexpr int ZPB = 32 * ZSB;
  static_assert(ZOFF + 2 * ZPB <= SMEM_BYTES, "hyena lds");
  const int lane = tid & 63, wid = tid >> 6, r = lane & 31, h = lane >> 5;
  const int lo = 1536 - 512 * tq;
  __syncthreads();
  for (int mth = tid; mth < 322; mth += 256) {
    const u32x4 v0 = *(const GAS u32x4*)(arr + lo + 8 * mth), v1 = *(const GAS u32x4*)(arr + lo + 8 * mth + 8);
    const unsigned D0 = v0.x, D1 = v0.y, D2 = v0.z, D3 = v0.w, D4 = v1.x, D5 = v1.y;
    u32x4 c0 = v0;
    u32x4 c1; c1.x = __builtin_amdgcn_alignbyte(D1, D0, 2); c1.y = __builtin_amdgcn_alignbyte(D2, D1, 2); c1.z = __builtin_amdgcn_alignbyte(D3, D2, 2); c1.w = __builtin_amdgcn_alignbyte(D4, D3, 2);
    u32x4 c2; c2.x = D1; c2.y = D2; c2.z = D3; c2.w = D4;
    u32x4 c3; c3.x = __builtin_amdgcn_alignbyte(D2, D1, 2); c3.y = __builtin_amdgcn_alignbyte(D3, D2, 2); c3.z = __builtin_amdgcn_alignbyte(D4, D3, 2); c3.w = __builtin_amdgcn_alignbyte(D5, D4, 2);
    *(u32x4*)(smem + 0 * CSB + 16 * mth) = c0;
    *(u32x4*)(smem + 1 * CSB + 16 * mth) = c1;
    *(u32x4*)(smem + 2 * CSB + 16 * mth) = c2;
    *(u32x4*)(smem + 3 * CSB + 16 * mth) = c3;
  }
  u32x4 zr[4];
  const int zb = tid >> 5, zc = tid & 31;
#pragma unroll
  for (int i = 0; i < 4; ++i) zr[i] = *(const GAS u32x4*)(zin + (size_t)(zb + 8 * i) * 2048 + zc * 8);
#pragma unroll
  for (int i = 0; i < 4; ++i) *(u32x4*)(smem + ZOFF + (zb + 8 * i) * ZSB + zc * 16) = zr[i];
  __syncthreads();
  f32x16 acc[4];
#pragma unroll
  for (int i = 0; i < 4; ++i)
#pragma unroll
    for (int e = 0; e < 16; ++e) acc[i][e] = 0.f;
  const int q = (3 - r) & 3;
  const char* gbase = smem + q * CSB + (511 - 128 * wid - r + 8 * h - q) * 2;
  for (int pnl = 0; pnl < 8; ++pnl) {
    const char* zs = smem + ZOFF + (pnl & 1) * ZPB;
    const bool more = (pnl + 1 < 8);
    if (more) {
#pragma unroll
      for (int i = 0; i < 4; ++i) zr[i] = *(const GAS u32x4*)(zin + (size_t)(zb + 8 * i) * 2048 + (pnl + 1) * 256 + zc * 8);
    }
    __builtin_amdgcn_sched_barrier(0);
#pragma unroll 4
    for (int sc = 0; sc < 16; ++sc) {
      const bf16x8 zf = *(const bf16x8*)(zs + r * ZSB + sc * 32 + h * 16);
      const char* gp = gbase + (pnl * 256 + sc * 16) * 2;
#pragma unroll
      for (int i = 0; i < 4; ++i) {
        const s16x4 g0 = *(const s16x4*)(gp - 64 * i), g1 = *(const s16x4*)(gp - 64 * i + 8);
        const bf16x8 gf = __builtin_shufflevector(g0, g1, 0, 1, 2, 3, 4, 5, 6, 7);
        acc[i] = mfma32(gf, zf, acc[i]);
      }
    }
    if (more) {
      char* zn = smem + ZOFF + ((pnl + 1) & 1) * ZPB;
#pragma unroll
      for (int i = 0; i < 4; ++i) *(u32x4*)(zn + (zb + 8 * i) * ZSB + zc * 16) = zr[i];
    }
    __syncthreads();
  }
#pragma unroll
  for (int i = 0; i < 4; ++i) {
    const int t0 = 512 * tq + 128 * wid + 32 * i;
#pragma unroll
    for (int g = 0; g < 4; ++g) {
      const size_t off = (size_t)r * 2048 + t0 + 8 * g + 4 * h;
      const u32x2 zw = *(const GAS u32x2*)(zin + off), xw = *(const GAS u32x2*)(xg + off);
      const float o0 = bflo(xw.x) * (acc[i][4 * g + 0] + bias * bflo(zw.x));
      const float o1 = bfhi(xw.x) * (acc[i][4 * g + 1] + bias * bfhi(zw.x));
      const float o2 = bflo(xw.y) * (acc[i][4 * g + 2] + bias * bflo(zw.y));
      const float o3 = bfhi(xw.y) * (acc[i][4 * g + 3] + bias * bfhi(zw.y));
      u32x2 w; w.x = pk2(o0, o1); w.y = pk2(o2, o3);
      *(GAS u32x2*)(zout + off) = w;
    }
  }
}

DI int wt_map(int mode, int d) {
  if (mode == 0) return d;
  if (mode == 1) { if (d < 640) return d; if (d < 2176) return d + 32; if (d < 2208) return d - 2176 + 640; return -1; }
  const int tile = d >> 7, w = d & 127;
  return (w < 64) ? (tile * 64 + w) : (2816 + tile * 64 + (w - 64));
}
DI void wt_item(const float* __restrict__ W, int ldw, int K, bf16_t* __restrict__ Wt, int k0, int d0, int mode, char* smem, int tid) {
  float* tile = (float*)smem;
  __syncthreads();
  {
    const int j = tid & 63, kq = tid >> 6;
    const int src = wt_map(mode, d0 + j);
#pragma unroll
    for (int i = 0; i < 16; ++i) {
      const int k = kq + 4 * i;
      tile[k * 65 + j] = (src >= 0) ? *(const GAS float*)(W + (size_t)(k0 + k) * ldw + src) : 0.f;
    }
  }
  __syncthreads();
#pragma unroll
  for (int u = 0; u < 2; ++u) {
    const int id = tid + 256 * u, j = id >> 3, k8 = (id & 7) * 8;
    float v[8];
#pragma unroll
    for (int e = 0; e < 8; ++e) v[e] = tile[(k8 + e) * 65 + j];
    u32x4 w; w.x = pk2(v[0], v[1]); w.y = pk2(v[2], v[3]); w.z = pk2(v[4], v[5]); w.w = pk2(v[6], v[7]);
    *(GAS u32x4*)(Wt + (size_t)(d0 + j) * K + k0 + k8) = w;
  }
}

DI void ada_item(const float* __restrict__ c, const float* __restrict__ cctx, const float* __restrict__ adaw, const float* __restrict__ adab, float* __restrict__ MODp, int item, char* smem, int tid) {
  const int layer = item / 192, rem = item % 192, nb = rem / 8, kc = rem % 8;
  float* s = (float*)smem;
  __syncthreads();
  for (int idx = tid; idx < 36 * 128; idx += 256) {
    const int k = idx / 36, rr = idx % 36;
    float v = 0.f;
    if (rr < 32) v = siluf(c[rr * 1024 + kc * 128 + k]); else if (rr == 32) v = siluf(cctx[kc * 128 + k]);
    s[idx] = v;
  }
  __syncthreads();
  const int n = nb * 256 + tid;
  const float* W = adaw + (size_t)layer * 1024 * 6144 + (size_t)(kc * 128) * 6144 + n;
  float acc[36];
  const float b0 = (kc == 0) ? adab[layer * 6144 + n] : 0.f;
#pragma unroll
  for (int rr = 0; rr < 36; ++rr) acc[rr] = b0;
#pragma unroll 2
  for (int k = 0; k < 128; ++k) {
    const float w = *(const GAS float*)(W + (size_t)k * 6144);
#pragma unroll
    for (int r4 = 0; r4 < 9; ++r4) {
      const f32x4 sv = *(const f32x4*)(s + k * 36 + 4 * r4);
      acc[4 * r4 + 0] += sv[0] * w; acc[4 * r4 + 1] += sv[1] * w; acc[4 * r4 + 2] += sv[2] * w; acc[4 * r4 + 3] += sv[3] * w;
    }
  }
  float* MOD = MODp + (size_t)layer * 33 * 6144 + n;
#pragma unroll
  for (int rr = 0; rr < 33; ++rr) unsafeAtomicAdd(MOD + (size_t)rr * 6144, acc[rr]);
}

DI void filt_item(const KParams* p, int item, char* smem, int tid) {
  float* feats = (float*)smem;
  float* h1 = feats + 8 * 33;
  float* h2 = h1 + 8 * 64;
  const float* w1 = p->in[23]; const float* b1 = p->in[24]; const float* w2 = p->in[25]; const float* b2 = p->in[26];
  const float* w3 = p->in[27]; const float* b3 = p->in[28]; const float* fq = p->in[29];
  const int t0 = item * 8;
  __syncthreads();
  for (int idx = tid; idx < 8 * 33; idx += 256) {
    const int tl = idx / 33, f = idx % 33; const float t = (float)(t0 + tl);
    float v;
    if (f == 0) v = t / 2047.f;
    else {
      const int band = (f - 1) & 15;
      const float bv = 1e-4f + (float)band * ((15.f - 1e-4f) / 15.f);
      const float ang = (6.283185307179586f * bv) * t / 2048.f;
      v = (f <= 16) ? cosf(ang) : -sinf(ang);
    }
    feats[idx] = v;
  }
  __syncthreads();
  for (int idx = tid; idx < 512; idx += 256) {
    const int tl = idx >> 6, j = idx & 63;
    float a = b1[j];
#pragma unroll 3
    for (int f = 0; f < 33; ++f) a += feats[tl * 33 + f] * w1[f * 64 + j];
    h1[idx] = sinf(fq[j] * a);
  }
  __syncthreads();
  for (int idx = tid; idx < 512; idx += 256) {
    const int tl = idx >> 6, j = idx & 63;
    float a = b2[j];
#pragma unroll 4
    for (int f = 0; f < 64; ++f) a += h1[tl * 64 + f] * w2[f * 64 + j];
    h2[idx] = sinf(fq[j] * a);
  }
  __syncthreads();
  bf16_t* GARR = (bf16_t*)(p->ws + OFF_GARR);
  const float min_decay = -3.0701134573253945f, max_decay = -15.350567286626973f;
#pragma unroll 1
  for (int ci = 0; ci < 8; ++ci) {
    const int col = tid + 256 * ci;
    float acc[8];
    const float bb = b3[col];
#pragma unroll
    for (int tl = 0; tl < 8; ++tl) acc[tl] = bb;
#pragma unroll 4
    for (int j = 0; j < 64; ++j) {
      const float w = w3[j * 2048 + col];
#pragma unroll
      for (int tl = 0; tl < 8; ++tl) acc[tl] += h2[tl * 64 + j] * w;
    }
    const int dir = col >> 10, n = (col >> 9) & 1, ch = col & 511;
    const float delta = fabsf(min_decay + (max_decay - min_decay) * ((float)ch / 511.f));
    bf16_t* dst = GARR + ((size_t)(n * 512 + ch)) * 4096;
#pragma unroll
    for (int tl = 0; tl < 8; ++tl) {
      const int t = t0 + tl;
      const float val = acc[tl] * expf(-((float)t / 2047.f) * delta);
      if (dir == 0) dst[2047 - t] = f2bf(val);
      else { if (t >= 1) dst[2047 + t] = f2bf(val); if (t == 2047) dst[4095] = 0; }
    }
  }
}

DI int xcd_item(int j, int xcd, int NX, int GS) { const int gl = j / GS, w = j - gl * GS; return (gl * NX + xcd) * GS + w; }
DI void gemm_tile_of(int j, int xcd, int NX, int NTn, int GN, int& mt, int& nt) {
  const int gs = 8 * GN, stl = j / gs, w = j - stl * gs, st = stl * NX + xcd, nsn = NTn / GN, sm = st / nsn, sn = st - sm * nsn;
  mt = sm * 8 + (w & 7); nt = sn * GN + (w >> 3);
}

#define XB_TMO      128
#define XB_XCNT(j)  (256  + 64 * (j))
#define XB_XSUB(j)  (1280 + 64 * (j))
#define XB_XGEN(j)  (2304 + 64 * (j))
#define XB_TOP      3328
#define XB_TOPGEN   3392
#define XB_SPIN_CAP (1u << 22)
DI unsigned xb_ld(unsigned* p)              { return __hip_atomic_load(p, __ATOMIC_RELAXED, __HIP_MEMORY_SCOPE_AGENT); }
DI unsigned xb_add(unsigned* p, unsigned v) { return __hip_atomic_fetch_add(p, v, __ATOMIC_RELAXED, __HIP_MEMORY_SCOPE_AGENT); }
DI unsigned xb_xcc_id() { return (unsigned)__builtin_amdgcn_s_getreg((3 << 11) | 20) & 0xFu; }
#define XB_SPIN(cond, bar) do { unsigned _sp = 0; while (cond) { __builtin_amdgcn_s_sleep(1); \
    if ((++_sp & 255u) == 0u) { if (xb_ld(&(bar)[XB_TMO])) break; if (_sp > XB_SPIN_CAP) { atomicAdd(&(bar)[XB_TMO], 1u); break; } } } } while (0)
DI void xcd_barrier_complete(unsigned* bar, unsigned x, unsigned& nloc, unsigned& nx) {
  const unsigned Gn = gridDim.x;
  unsigned sum, cnt, mine, sp = 0u;
  for (;;) {
    sum = 0u; cnt = 0u; mine = 0u;
#pragma unroll
    for (unsigned j = 0; j < 16; ++j) { const unsigned c = xb_ld(&bar[XB_XCNT(j)]); sum += c; cnt += (c > 0u) ? 1u : 0u; mine = (j == x) ? c : mine; }
    if (sum == Gn) break;
    __builtin_amdgcn_s_sleep(1);
    if ((++sp & 255u) == 0u) { if (xb_ld(&bar[XB_TMO])) break; if (sp > XB_SPIN_CAP) { atomicAdd(&bar[XB_TMO], 1u); break; } }
  }
  nloc = mine > 0u ? mine : 1u; nx = cnt > 0u ? cnt : 1u;
}
DI void xcd_barrier(unsigned* bar, unsigned x, volatile LAS unsigned* st) {
  asm volatile("s_waitcnt vmcnt(0)" ::: "memory");
  __syncthreads();
  if (threadIdx.x == 0) {
    __builtin_amdgcn_s_waitcnt(0);
    unsigned nloc = st[0], nx = st[1];
    if (nloc == 0u) { xcd_barrier_complete(bar, x, nloc, nx); st[0] = nloc; st[1] = nx; }
    const unsigned old = xb_add(&bar[XB_XSUB(x)], 1u);
    const unsigned gen = old / nloc;
    if (old + 1u == (gen + 1u) * nloc) {
      __builtin_amdgcn_fence(__ATOMIC_RELEASE, "agent");
      asm volatile("s_waitcnt vmcnt(0)" ::: "memory");
      const unsigned og = xb_add(&bar[XB_TOP], 1u);
      const unsigned tg = og / nx;
      if (og + 1u == (tg + 1u) * nx) xb_add(&bar[XB_TOPGEN], 1u);
      else XB_SPIN(xb_ld(&bar[XB_TOPGEN]) == tg, bar);
      __builtin_amdgcn_fence(__ATOMIC_ACQUIRE, "agent");
      xb_add(&bar[XB_XGEN(x)], 1u);
      asm volatile("s_waitcnt vmcnt(0)" ::: "memory");
    } else {
      XB_SPIN(xb_ld(&bar[XB_XGEN(x)]) == gen, bar);
      __builtin_amdgcn_fence(__ATOMIC_ACQUIRE, "agent");
      asm volatile("s_waitcnt vmcnt(0)" ::: "memory");
    }
  }
  __syncthreads();
}

__global__ void __launch_bounds__(256, 2) fwd_kernel(Params p) {
  extern __shared__ __attribute__((aligned(16))) char smem[];
  cg::grid_group grid = cg::this_grid();
  const int G = gridDim.x, bid = blockIdx.x, NW = G * 4;
  __shared__ uint4 xb_words;
  if (threadIdx.x == 0) xb_words = make_uint4(0u, 0u, 0u, 0u);
  __syncthreads();
  unsigned* const xbar = (unsigned*)(p.ws + OFF_BAR);
  const unsigned xb_x = xb_xcc_id();
  if (threadIdx.x == 0) (void)xb_add(&xbar[XB_XCNT(xb_x)], 1u);
  const int NX = ((G & 7) == 0) ? 8 : 1, xcd = bid % NX, slot = bid / NX, nslot = G / NX;
#define WT_IN0 ((const bf16_t*)(ws + OFF_WT_IN0))
#define WT_UQ ((const bf16_t*)(ws + OFF_WT_UQ))
#define WT_UKV ((const bf16_t*)(ws + OFF_WT_UKV))
#define WT_IN1 ((const bf16_t*)(ws + OFF_WT_IN1))
#define MOD ((float*)(ws + OFF_MOD))
#define CS64 ((const f32x2*)(ws + OFF_CS64))
#define CS32 ((const f32x2*)(ws + OFF_CS32))
#define XC ((float*)(ws + OFF_XC))
#define XL (pp->out)
#define H ((bf16_t*)(ws + OFF_H))
#define P ((bf16_t*)(ws + OFF_P))
#define Q ((bf16_t*)(ws + OFF_Q))
#define KV ((bf16_t*)(ws + OFF_KV))
#define MI ((bf16_t*)(ws + OFF_MI))
#define Y ((bf16_t*)(ws + OFF_Y))
#define GB ((bf16_t*)(ws + OFF_G))
#define BND ((float*)(ws + OFF_BND))
#define HT ((bf16_t*)(ws + OFF_HT))
#define Z1T ((bf16_t*)(ws + OFF_Z1T))
#define Z2T ((bf16_t*)(ws + OFF_Z2T))
#define norm_g (pp->in[6])

#ifdef PROBE_MASK
  bool rep_done = false;
#endif
  for (int ph = p.ph_lo; ph < p.ph_hi; ++ph) {
    int tid = threadIdx.x; asm volatile("" : "+v"(tid));
    const KParams* pp = (const KParams*)__builtin_amdgcn_kernarg_segment_ptr(); asm volatile("" : "+s"(pp));
    char* ws = pp->ws; asm volatile("" : "+s"(ws));
    const int lane = tid & 63, wid = __builtin_amdgcn_readfirstlane(tid >> 6);
    const int gw = bid * 4 + wid;
    if (ph == 0) {
      for (int item = bid; item < 1024 + 6024; item += G) {
        if (item < 256) filt_item(pp, item, smem, tid);
        else if (item < 640) ada_item(pp->in[1], pp->in[3], pp->in[4], pp->in[5], (float*)(ws + OFF_MOD), item - 256, smem, tid);
        else if (item < 1024) {
          const int idx = (item - 640) * 256 + tid;
          const int t = idx / 48, e = idx % 48;
          const float row = (float)(t >> 6), col = (float)(t & 63);
          if (e < 32) { const int i = e; const float inv = exp2f(-(float)(i & 15) * (13.287712379549449f / 16.f)); const float ang = ((i < 16) ? row : col) * inv;
            ((f32x2*)(ws + OFF_CS64))[t * 32 + i] = (f32x2){cosf(ang), sinf(ang)}; }
          else { const int i = e - 32; const float inv = exp2f(-(float)(i & 7) * (13.287712379549449f / 8.f)); const float ang = ((i < 8) ? row : col) * inv;
            ((f32x2*)(ws + OFF_CS32))[t * 16 + i] = (f32x2){cosf(ang), sinf(ang)}; }
        } else {
          int r = item - 1024;
          const float* W; int ldw, K, nd, mode = 0; size_t off;
          if (r < 576) { W = pp->in[12]; ldw = 2208; K = 1024; nd = 36; mode = 1; off = OFF_WT_IN0; }
          else if ((r -= 576) < 72) { W = pp->in[14]; ldw = 768; K = 384; nd = 12; off = OFF_WT_UQ; }
          else if ((r -= 72) < 64) { W = pp->in[16]; ldw = 1024; K = 256; nd = 16; off = OFF_WT_UKV; }
          else if ((r -= 64) < 256) { W = pp->in[7]; ldw = 1024; K = 1024; nd = 16; off = OFF_WT_OUT0; }
          else if ((r -= 256) < 256) { W = pp->in[7] + 1048576; ldw = 1024; K = 1024; nd = 16; off = OFF_WT_OUT1; }
          else if ((r -= 256) < 1408) { W = pp->in[8]; ldw = 5632; K = 1024; nd = 88; mode = 2; off = OFF_WT_UP0; }
          else if ((r -= 1408) < 1408) { W = pp->in[8] + (size_t)1024 * 5632; ldw = 5632; K = 1024; nd = 88; mode = 2; off = OFF_WT_UP1; }
          else if ((r -= 1408) < 704) { W = pp->in[11]; ldw = 1024; K = 2816; nd = 16; off = OFF_WT_DN0; }
          else if ((r -= 704) < 704) { W = pp->in[11] + (size_t)2816 * 1024; ldw = 1024; K = 2816; nd = 16; off = OFF_WT_DN1; }
          else { r -= 704; W = pp->in[19]; ldw = 2304; K = 1024; nd = 36; off = OFF_WT_IN1; }
          const int kt = r / nd, dt = r % nd;
          wt_item(W, ldw, K, (bf16_t*)(ws + off), kt * 64, dt * 64, mode, smem, tid);
        }
      }
    }
    else if (ph == 1) {
      for (int gi = gw; gi < NT / 4; gi += NW) {
        const int row = gi * 4;
        const int mr = (row < NL) ? (row >> 11) : 32;
        const float* md = MOD + (size_t)mr * 6144;
        RowIO4 io;
        io.xin = (row < NL) ? pp->in[0] + (size_t)row * 1024 : pp->in[2] + (size_t)(row - NL) * 1024;
        io.y = nullptr; io.gate = nullptr; io.xout = nullptr; io.shift = md; io.scale = md + 1024; io.hout = H + (size_t)row * 1024;
        rw_rows4(io, nullptr, norm_g, lane);
      }
    }
    else if (ph == 2) {
      const EpiArgs ea{P, PLD, nullptr, nullptr, nullptr};
      for (int j = slot; j < 576 * 9 / NX; j += nslot) { int mt, nt; gemm_tile_of(j, xcd, NX, 9, 9, mt, nt);
        gemm_tile256<0>(H, 1024, WT_IN0, 1024, mt, nt, smem, tid, ea); }
    }
    else if (ph == 3) {
      const float* gq = pp->in[13]; const float* gkv = pp->in[15];
      for (int row = gw; row < NT; row += NW) {
        unsigned wq[3], wk[2], d0[2], d1[2], kr0 = 0, kr1 = 0;
        f32x4 cd[2], ck = {0.f, 0.f, 0.f, 0.f};
        const bool lat = row < NL;
        const int t = row & 2047;
        bf16_t* pr = P + (size_t)row * PLD;
#pragma unroll
        for (int i = 0; i < 3; ++i) wq[i] = *(const GAS unsigned*)(pr + PE_CQ + 2 * lane + 128 * i);
#pragma unroll
        for (int i = 0; i < 2; ++i) wk[i] = *(const GAS unsigned*)(pr + PE_CKV + 2 * lane + 128 * i);
        if (lat) {
#pragma unroll
          for (int u = 0; u < 2; ++u) {
            const int dp = lane + 64 * u, grp = dp >> 4, i2 = (dp & 15) * 2;
            d0[u] = *(const GAS unsigned*)(pr + PE_DK + grp * 64 + i2);
            d1[u] = *(const GAS unsigned*)(pr + PE_DK + grp * 64 + i2 + 32);
            cd[u] = *(const GAS f32x4*)((const float*)(CS64 + t * 32 + i2));
          }
          if (lane < 8) {
            kr0 = *(const GAS unsigned*)(pr + PE_KR + 2 * lane);
            kr1 = *(const GAS unsigned*)(pr + PE_KR + 2 * lane + 16);
            ck = *(const GAS f32x4*)((const float*)(CS32 + t * 16 + 2 * lane));
          }
        }
        f32x2 g2q[3], g2k[2];
#pragma unroll
        for (int i = 0; i < 3; ++i) g2q[i] = *(const GAS f32x2*)(gq + 2 * lane + 128 * i);
#pragma unroll
        for (int i = 0; i < 2; ++i) g2k[i] = *(const GAS f32x2*)(gkv + 2 * lane + 128 * i);
        float ss = 0.f;
#pragma unroll
        for (int i = 0; i < 3; ++i) { const float a = bflo(wq[i]), bq = bfhi(wq[i]); ss += a * a + bq * bq; }
        const float rq = rsqrtf(wave_sum(ss) * (1.f / 384.f) + 1e-6f);
        float s2 = 0.f;
#pragma unroll
        for (int i = 0; i < 2; ++i) { const float a = bflo(wk[i]), bq = bfhi(wk[i]); s2 += a * a + bq * bq; }
        const float rk = rsqrtf(wave_sum(s2) * (1.f / 256.f) + 1e-6f);
#pragma unroll
        for (int i = 0; i < 3; ++i) *(GAS unsigned*)(pr + PE_CQ + 2 * lane + 128 * i) = pk2(bflo(wq[i]) * rq * g2q[i].x, bfhi(wq[i]) * rq * g2q[i].y);
#pragma unroll
        for (int i = 0; i < 2; ++i) *(GAS unsigned*)(pr + PE_CKV + 2 * lane + 128 * i) = pk2(bflo(wk[i]) * rk * g2k[i].x, bfhi(wk[i]) * rk * g2k[i].y);
        if (lat) {
#pragma unroll
          for (int u = 0; u < 2; ++u) {
            const int dp = lane + 64 * u, grp = dp >> 4, i2 = (dp & 15) * 2;
            const float xa0 = bflo(d0[u]), xa1 = bfhi(d0[u]), xb0 = bflo(d1[u]), xb1 = bfhi(d1[u]);
            const f32x4 c4 = cd[u];
            *(GAS unsigned*)(pr + PE_DK + grp * 64 + i2) = pk2(xa0 * c4[0] - xb0 * c4[1], xa1 * c4[2] - xb1 * c4[3]);
            *(GAS unsigned*)(pr + PE_DK + grp * 64 + i2 + 32) = pk2(xa0 * c4[1] + xb0 * c4[0], xa1 * c4[3] + xb1 * c4[2]);
          }
          if (lane < 8) {
            const float xa0 = bflo(kr0), xa1 = bfhi(kr0), xb0 = bflo(kr1), xb1 = bfhi(kr1);
            *(GAS unsigned*)(pr + PE_KR + 2 * lane) = pk2(xa0 * ck[0] - xb0 * ck[1], xa1 * ck[2] - xb1 * ck[3]);
            *(GAS unsigned*)(pr + PE_KR + 2 * lane + 16) = pk2(xa0 * ck[1] + xb0 * ck[0], xa1 * ck[3] + xb1 * ck[2]);
          }
        }
      }
    }
    else if (ph == 4) {
      const EpiArgs eq{Q, 768, nullptr, nullptr, nullptr}, ekv{KV, 1024, nullptr, nullptr, nullptr};
      for (int j = slot; j < 576 * 7 / NX; j += nslot) {
        int mt, nt;
        if (j < 576 * 3 / NX) { gemm_tile_of(j, xcd, NX, 3, 3, mt, nt); gemm_tile256<0>(P + PE_CQ, PLD, WT_UQ, 384, mt, nt, smem, tid, eq); }
        else { gemm_tile_of(j - 576 * 3 / NX, xcd, NX, 4, 4, mt, nt); gemm_tile256<0>(P + PE_CKV, PLD, WT_UKV, 256, mt, nt, smem, tid, ekv); }
      }
    }
    else if (ph == 5) {   }
    else if (ph == 6) {
      const int r = lane & 31, h = lane >> 5;
      for (int j = nslot - 1 - slot; j < 2304 / NX; j += nslot) {
        const int item = (j < 2048 / NX) ? xcd_item(j, xcd, NX, 16) : 2048 + (j - 2048 / NX) * NX + xcd;
        const bool is_ctx = (item >= 2048);
        {
          int b, hh, qt, qrow0;
          if (!is_ctx) { const int idx = item; b = idx >> 6; hh = (idx >> 4) & 3; qt = idx & 15; qrow0 = b * 2048 + qt * 128; }
          else { const int idx = item - 2048; b = idx >> 3; hh = (idx >> 1) & 3; qt = idx & 1; qrow0 = NL + b * 256 + qt * 128; }
          const int qr = qrow0 + wid * 32 + r;
          const float c = 0.125f * 1.4426950408889634f;
          bf16_t* outp = MI + (size_t)qr * 1024 + 512 + hh * 128;
          float lam;
          { const float* dl = pp->in[17]; const float a = wave_sum(dl[lane] * dl[64 + lane]), bq = wave_sum(dl[128 + lane] * dl[192 + lane]); lam = __expf(a) - __expf(bq) + 0.2f; }
          float ss = 0.f;
#pragma unroll 1
          for (int sm = 0; sm < 2; ++sm) {
            bf16x8 qf[4];
            load_q<64, 0, 64>(qf, P + (size_t)qr * PLD + PE_DQ + hh * 128 + sm * 64, h, !is_ctx, CS64 + (size_t)(qr & 2047) * 32);
            f32x16 O[4];
#pragma unroll
            for (int t = 0; t < 4; ++t)
#pragma unroll
              for (int e = 0; e < 16; ++e) O[t][e] = 0.f;
            float m = -1e30f, l = 0.f;
            const bf16_t* kp = P + PE_DK + hh * 128 + sm * 64; const bf16_t* vp = P + PE_DV + hh * 128;
            attn_pass<64, 128, 64, 0>(smem, qf, kp, PLD, kp, PLD, vp, PLD, b, qt, is_ctx ? 4 : 36, c, O, m, l, tid);
            l += __shfl_xor(l, 32);
            const float inv = 1.f / l;
            if (sm == 0) {
              attn_store<4>(O, inv, outp, h);
            } else {
#pragma unroll
              for (int t = 0; t < 4; ++t)
#pragma unroll
                for (int g = 0; g < 4; ++g) {
                  const u32x2 w = *(const GAS u32x2*)(outp + 32 * t + 8 * g + 4 * h);
                  const float v0 = bflo(w.x) - lam * O[t][4 * g + 0] * inv, v1 = bfhi(w.x) - lam * O[t][4 * g + 1] * inv;
                  const float v2 = bflo(w.y) - lam * O[t][4 * g + 2] * inv, v3 = bfhi(w.y) - lam * O[t][4 * g + 3] * inv;
                  ss += v0 * v0 + v1 * v1 + v2 * v2 + v3 * v3;
                  O[t][4 * g + 0] = v0; O[t][4 * g + 1] = v1; O[t][4 * g + 2] = v2; O[t][4 * g + 3] = v3;
                }
              attn_store<4>(O, 1.f, outp, h);
            }
          }
          ss += __shfl_xor(ss, 32);
          const float rinv = rsqrtf(ss * (1.f / 128.f) + 1e-6f) * 0.8f;
          const float* subg = pp->in[18];
#pragma unroll
          for (int t = 0; t < 4; ++t)
#pragma unroll
            for (int g = 0; g < 4; ++g) {
              bf16_t* a = outp + 32 * t + 8 * g + 4 * h;
              const u32x2 w = *(const GAS u32x2*)a;
              const f32x4 g4 = *(const GAS f32x4*)(subg + 32 * t + 8 * g + 4 * h);
              u32x2 o; o.x = pk2(bflo(w.x) * rinv * g4[0], bfhi(w.x) * rinv * g4[1]); o.y = pk2(bflo(w.y) * rinv * g4[2], bfhi(w.y) * rinv * g4[3]);
              *(GAS u32x2*)a = o;
            }
        }
      }
      for (int j = slot; j < 4608 / NX; j += nslot) {
        const int item = (j < 4096 / NX) ? xcd_item(j, xcd, NX, 16) : 4096 + (j - 4096 / NX) * NX + xcd;
        const bool is_ctx = (item >= 4096);
        {
          int b, hh, qt, qrow0;
          if (!is_ctx) { const int idx = item; b = idx >> 7; hh = (idx >> 4) & 7; qt = idx & 15; qrow0 = b * 2048 + qt * 128; }
          else { const int idx = item - 4096; b = idx >> 4; hh = (idx >> 1) & 7; qt = idx & 1; qrow0 = NL + b * 256 + qt * 128; }
          const int qr = qrow0 + wid * 32 + r;
          bf16x8 qf[6];
          load_q<96, 64, 32>(qf, Q + (size_t)qr * 768 + hh * 96, h, !is_ctx, CS32 + (size_t)(qr & 2047) * 16);
          f32x16 O[2];
#pragma unroll
          for (int t = 0; t < 2; ++t)
#pragma unroll
            for (int e = 0; e < 16; ++e) O[t][e] = 0.f;
          float m = -1e30f, l = 0.f;
          const float c = 0.10206207261596575f * 1.4426950408889634f;
          attn_pass<96, 64, 64, 0>(smem, qf, KV + hh * 128, 1024, P + PE_KR, PLD, KV + hh * 128 + 64, 1024, b, qt, is_ctx ? 4 : 36, c, O, m, l, tid);
          l += __shfl_xor(l, 32);
          attn_store<2>(O, 1.f / l, MI + (size_t)qr * 1024 + hh * 64, h);
        }
      }
    }
    else if (ph == 7 || ph == 18) {
      const int nmt = (ph == 7) ? 576 : 512;
      const bf16_t* Wt = (const bf16_t*)(ws + ((ph == 7) ? OFF_WT_OUT0 : OFF_WT_OUT1));
      const EpiArgs ea{Y, 1024, nullptr, nullptr, nullptr};
      for (int j = slot; j < nmt * 4 / NX; j += nslot) { int mt, nt; gemm_tile_of(j, xcd, NX, 4, 4, mt, nt);
        gemm_tile256<0>(MI, 1024, Wt, 1024, mt, nt, smem, tid, ea); }
    }
    else if (ph == 8 || ph == 12 || ph == 19 || ph == 23) {
      const int layer = (ph >= 19) ? 1 : 0;
      const bool second = (ph == 12 || ph == 23);
      const int nrows = (ph >= 19) ? NL : NT;
      const float* ga = norm_g + (size_t)layer * 4096 + (second ? 3072 : 1024);
      const float* gb = second ? (norm_g + 4096) : (norm_g + (size_t)layer * 4096 + 2048);
      for (int gi = gw; gi < nrows / 4; gi += NW) {
        const int row = gi * 4;
        const bool lat = row < NL;
        const int mr = lat ? (row >> 11) : 32;
        const float* md = MOD + ((size_t)layer * 33 + mr) * 6144;
        RowIO4 io;
        if (lat) { io.xin = (ph == 8) ? pp->in[0] + (size_t)row * 1024 : XL + (size_t)row * 1024; io.xout = XL + (size_t)row * 1024; }
        else { io.xin = (ph == 8) ? pp->in[2] + (size_t)(row - NL) * 1024 : XC + (size_t)(row - NL) * 1024; io.xout = XC + (size_t)(row - NL) * 1024; }
        io.y = Y + (size_t)row * 1024;
        io.gate = md + (second ? 5120 : 2048);
        if (ph == 23) { io.shift = nullptr; io.scale = nullptr; io.hout = nullptr; }
        else if (ph == 12) { const float* md1 = MOD + ((size_t)33 + mr) * 6144; io.shift = md1; io.scale = md1 + 1024; io.hout = H + (size_t)row * 1024; }
        else { io.shift = md + 3072; io.scale = md + 4096; io.hout = H + (size_t)row * 1024; }
        rw_rows4(io, ga, gb, lane);
      }
    }
    else if (ph == 9 || ph == 20) {
      const int layer = (ph == 20) ? 1 : 0, nmt = (ph == 9) ? 576 : 512;
      const bf16_t* Wt = (const bf16_t*)(ws + (layer ? OFF_WT_UP1 : OFF_WT_UP0));
      const float* cw = pp->in[9] + (size_t)layer * 3 * 5632; const float* cb = pp->in[10] + (size_t)layer * 5632;
      const EpiArgs ea{GB, 2816, BND, cw, cb};
#ifdef PROBE_GEMM_VAR
      if (ph == 9) {
        for (int j = slot; j < nmt * 22 / NX; j += nslot) { int mt, nt; gemm_tile_of(j, xcd, NX, 22, 11, mt, nt);
          gemm_tile256<1, PROBE_GEMM_VAR>(H, 1024, Wt, 1024, mt, nt, smem, tid, ea); }
        grid.sync();
      }
#endif
      for (int j = slot; j < nmt * 22 / NX; j += nslot) { int mt, nt; gemm_tile_of(j, xcd, NX, 22, 11, mt, nt);
        gemm_tile256<1>(H, 1024, Wt, 1024, mt, nt, smem, tid, ea); }
    }
    else if (ph == 10 || ph == 21) {
      const int layer = (ph == 21) ? 1 : 0, nmt = (ph == 10) ? 576 : 512;
      const float* cw = pp->in[9] + (size_t)layer * 3 * 5632; const float* cb = pp->in[10] + (size_t)layer * 5632;
      for (int item = bid; item < nmt * 2; item += G) {
        const int mt = item >> 1, side = item & 1, m0 = mt * 128, L = (mt < 512) ? 2048 : 256;
        const float *pv, *cu, *nx; int orow;
        if (side == 0) { if ((m0 % L) == 0) continue; pv = BND + (size_t)((mt - 1) * 4 + 3) * 5632; cu = BND + (size_t)(mt * 4 + 0) * 5632; nx = BND + (size_t)(mt * 4 + 1) * 5632; orow = m0; }
        else { if (((m0 + 128) % L) == 0) continue; pv = BND + (size_t)(mt * 4 + 2) * 5632; cu = BND + (size_t)(mt * 4 + 3) * 5632; nx = BND + (size_t)((mt + 1) * 4 + 0) * 5632; orow = m0 + 127; }
        for (int j = tid; j < 2816; j += 256) {
          const int ca = (j >> 6) * 128 + (j & 63), cgc = ca + 64;
          const float ua = cw[j] * pv[ca] + cw[5632 + j] * cu[ca] + cw[11264 + j] * nx[ca] + cb[j];
          const float ug = cw[2816 + j] * pv[cgc] + cw[5632 + 2816 + j] * cu[cgc] + cw[11264 + 2816 + j] * nx[cgc] + cb[2816 + j];
          GB[(size_t)orow * 2816 + j] = f2bf(siluf(ug) * ua);
        }
      }
    }
    else if (ph == 11 || ph == 22) {
      const int layer = (ph == 22) ? 1 : 0, nmt = (ph == 11) ? 576 : 512;
      const bf16_t* Wt = (const bf16_t*)(ws + (layer ? OFF_WT_DN1 : OFF_WT_DN0));
      const EpiArgs ea{Y, 1024, nullptr, nullptr, nullptr};
      for (int j = slot; j < nmt * 4 / NX; j += nslot) { int mt, nt; gemm_tile_of(j, xcd, NX, 4, 4, mt, nt);
        gemm_tile256<0>(GB, 2816, Wt, 2816, mt, nt, smem, tid, ea); }
    }
    else if (ph == 13) {
      const EpiArgs ea{P, PLD, nullptr, nullptr, nullptr};
      for (int j = slot; j < (512 * 9 + 64) / NX; j += nslot) {
        int mt, nt;
        if (j < 512 * 9 / NX) gemm_tile_of(j, xcd, NX, 9, 9, mt, nt); else { mt = 512 + (j - 512 * 9 / NX) * NX + xcd; nt = 2; }
        gemm_tile256<0>(H, 1024, WT_IN1, 1024, mt, nt, smem, tid, ea);
      }
    }
    else if (ph == 14) {
      for (int row = gw; row < NL; row += NW) {
        const int t = row & 2047, grp = lane >> 5, ii = lane & 31;
        bf16_t* a = P + (size_t)row * PLD + 512 + grp * 64 + ii;
        const f32x2 cs = CS64[t * 32 + ii];
        const float x1 = bf2f(a[0]), x2 = bf2f(a[32]);
        a[0] = f2bf(x1 * cs.x - x2 * cs.y); a[32] = f2bf(x1 * cs.y + x2 * cs.x);
      }
      const float* hw = pp->in[21]; const float* hb = pp->in[22];
      float* us = (float*)smem;
      for (int item = bid; item < 32 * 32 * 24; item += G) {
        const int ct = item % 24, tt = (item / 24) & 31, b = item / 768;
        const int t0 = tt * 64;
        __syncthreads();
#pragma unroll
        for (int i = 0; i < 3; ++i) {
          const int id = tid + 256 * i;
          if (id < 528) {
            const int rr = id >> 3, ch8 = (id & 7) * 8, t = t0 - 1 + rr;
            u32x4 v = {0u, 0u, 0u, 0u};
            if (t >= 0 && t < 2048) v = *(const GAS u32x4*)(P + (size_t)(b * 2048 + t) * PLD + 768 + ct * 64 + ch8);
            float* d = us + rr * 65 + ch8;
            d[0] = bflo(v.x); d[1] = bfhi(v.x); d[2] = bflo(v.y); d[3] = bfhi(v.y); d[4] = bflo(v.z); d[5] = bfhi(v.z); d[6] = bflo(v.w); d[7] = bfhi(v.w);
          }
        }
        __syncthreads();
#pragma unroll
        for (int k = 0; k < 2; ++k) {
          const int id = tid + 256 * k, ch = id >> 3, t8 = id & 7, cgl = ct * 64 + ch;
          const float w0 = hw[cgl], w1 = hw[1536 + cgl], w2 = hw[3072 + cgl], bb = hb[cgl];
          float v[8];
#pragma unroll
          for (int e = 0; e < 8; ++e) { const int tl = t8 * 8 + e; v[e] = w0 * us[tl * 65 + ch] + w1 * us[(tl + 1) * 65 + ch] + w2 * us[(tl + 2) * 65 + ch] + bb; }
          u32x4 w; w.x = pk2(v[0], v[1]); w.y = pk2(v[2], v[3]); w.z = pk2(v[4], v[5]); w.w = pk2(v[6], v[7]);
          *(GAS u32x4*)(HT + (size_t)cgl * 65536 + b * 2048 + t0 + t8 * 8) = w;
        }
      }
    }
    else if (ph == 15 || ph == 16) {
      const int order = ph - 15;
      const bf16_t* GARR = (const bf16_t*)(ws + OFF_GARR);
      const float* hbias = pp->in[30];
      const int nitems = (ph == 15) ? (2048 + 4096) : 2048;
      for (int j = slot; j < nitems / NX; j += nslot) {
        const int item = (j < 2048 / NX) ? xcd_item(j, xcd, NX, 4) : 2048 + xcd_item(j - 2048 / NX, xcd, NX, 64);
        if (item < 2048) {
          const int ch = item >> 2, tq = item & 3;
          const bf16_t* zin = (order == 0) ? HT + (size_t)ch * 65536 : Z1T + (size_t)ch * 65536;
          const bf16_t* xg = HT + (size_t)((order + 1) * 512 + ch) * 65536;
          bf16_t* zo = ((order == 0) ? Z1T : Z2T) + (size_t)ch * 65536;
          hyena_item(smem, zin, xg, GARR + (size_t)(order * 512 + ch) * 4096, hbias[order * 512 + ch], zo, tq, tid);
        } else {
          const int idx = item - 2048, b = idx >> 7, hq = (idx >> 4) & 7, qn = idx & 15, hk = hq >> 2;
          const int r = lane & 31, h = lane >> 5;
          const int qr = b * 2048 + qn * 128 + wid * 32 + r;
          bf16x8 qf[4];
          load_q<64, 0, 64>(qf, P + (size_t)qr * PLD + hq * 64, h, true, CS64 + (size_t)(qr & 2047) * 32);
          f32x16 O[2];
#pragma unroll
          for (int t = 0; t < 2; ++t)
#pragma unroll
            for (int e = 0; e < 16; ++e) O[t][e] = 0.f;
          float m = -1e30f, l = 0.f;
          const float c = 0.125f * 1.4426950408889634f;
          const bf16_t* kp = P + 512 + hk * 64; const bf16_t* vp = P + 640 + hk * 64;
          attn_pass<64, 64, 64, 2>(smem, qf, kp, PLD, kp, PLD, vp, PLD, b, qn, 0, c, O, m, l, tid);
          l += __shfl_xor(l, 32);
          l += __builtin_amdgcn_exp2f(pp->in[20][hq] * 1.4426950408889634f - m * c);
          attn_store<2>(O, 1.f / l, MI + (size_t)qr * 1024 + hq * 64, h);
        }
      }
    }
    else if (ph == 17) {
      bf16_t* tl = (bf16_t*)smem;
      for (int item = bid; item < 1024 * 8; item += G) {
        const int ct = item & 7, rt = item >> 3, r0 = rt * 64;
        __syncthreads();
#pragma unroll
        for (int u = 0; u < 2; ++u) { const int id = tid + 256 * u, ch = id >> 3, r8 = (id & 7) * 8;
          *(u32x4*)(tl + ch * 72 + r8) = *(const GAS u32x4*)(Z2T + (size_t)(ct * 64 + ch) * 65536 + r0 + r8); }
        __syncthreads();
#pragma unroll
        for (int u = 0; u < 2; ++u) { const int id = tid + 256 * u, rr = id >> 3, c8 = (id & 7) * 8;
          unsigned short v[8];
#pragma unroll
          for (int e = 0; e < 8; ++e) v[e] = tl[(c8 + e) * 72 + rr];
          u32x4 w; w.x = v[0] | ((unsigned)v[1] << 16); w.y = v[2] | ((unsigned)v[3] << 16); w.z = v[4] | ((unsigned)v[5] << 16); w.w = v[6] | ((unsigned)v[7] << 16);
          *(GAS u32x4*)(MI + (size_t)(r0 + rr) * 1024 + 512 + ct * 64 + c8) = w; }
      }
    }
#ifdef PROBE_MASK
    if (((PROBE_MASK >> ph) & 1) && !rep_done) { rep_done = true; xcd_barrier(xbar, xb_x, (volatile LAS unsigned*)&xb_words); --ph; continue; }
    rep_done = false;
#endif
    if (ph + 1 < p.ph_hi && ph != 4) {
      if (p.ph_hi > NPH) grid.sync();
      xcd_barrier(xbar, xb_x, (volatile LAS unsigned*)&xb_words);
    }
  }
}

extern "C" void kernel_launch(void* const* d_in, const int* in_sizes, int n_in, void* d_out, int out_size, void* d_ws, size_t ws_size, hipStream_t stream) {
  static int grid_blocks = 0;
  if (!grid_blocks) {
    int dev = 0, cus = 0, per_cu = 0;
    hipGetDevice(&dev);
    hipDeviceGetAttribute(&cus, hipDeviceAttributeMultiprocessorCount, dev);
    hipFuncSetAttribute((const void*)fwd_kernel, hipFuncAttributeMaxDynamicSharedMemorySize, SMEM_BYTES);
    hipOccupancyMaxActiveBlocksPerMultiprocessor(&per_cu, (const void*)fwd_kernel, 256, SMEM_BYTES);
    per_cu = 2;
    grid_blocks = cus * per_cu;
    if (ws_size < WS_END) fprintf(stderr, "kernel_launch: workspace too small: %zu < %zu\n", ws_size, (size_t)WS_END);
  }
  hipMemsetAsync((char*)d_ws + OFF_MOD, 0, MOD_BYTES + BAR_BYTES, stream);
  Params p{};
  for (int i = 0; i < 31; ++i) p.in[i] = (const float*)d_in[i];
  p.out = (float*)d_out; p.ws = (char*)d_ws;
#if MULTI_LAUNCH
  for (int ph = 0; ph < NPH; ++ph) {
    if (ph == 5) continue;
    p.ph_lo = ph; p.ph_hi = ph + 1;
    hipLaunchKernelGGL(fwd_kernel, dim3(grid_blocks), dim3(256), SMEM_BYTES, stream, p);
  }
#else
  p.ph_lo = 0; p.ph_hi = NPH;
  void* args[] = {&p};
  hipError_t e = hipLaunchCooperativeKernel((void*)fwd_kernel, dim3(grid_blocks), dim3(256), args, SMEM_BYTES, stream);
  if (e != hipSuccess) fprintf(stderr, "cooperative launch failed: %s (grid %d)\n", hipGetErrorString(e), grid_blocks);
#endif
}
```
